# Optimizing an MI355X kernel written in HIP

```python
import math
import jax
import jax.numpy as jnp
from jax import lax
import numpy as np

D_MODEL = 2048
BATCH = 8
SEQ = 2048
DEPTH = 1
DEC_BATCH = 128
DEC_SEQ = 8
PAST_LEN = 2048
PAGE_SIZE = 128

GLA_HEADS = 4
GLA_DK = 128
GLA_DV = 256
GLA_GATE_RANK = 16
GLA_TAU = 16.0
GLA_CHUNK = 64
GLA_WIDTH = GLA_HEADS * GLA_DV
NSA_HEADS = 16
NSA_KV = 4
NSA_GROUP = NSA_HEADS // NSA_KV
NSA_HD = 64
NSA_WIDTH = NSA_HEADS * NSA_HD
CMP_LEN = 32
CMP_STRIDE = 16
CMP_HIDDEN = 2 * NSA_HD
SEL_LEN = 64
SEL_TOPN = 16
WINDOW = 512
Q_BLOCK = 128
ROPE_THETA = 10000.0
MIX_WIDTH = GLA_WIDTH + NSA_WIDTH
D_FF = 5632
LN_EPS = 1e-5
ALPHA = (2.0 * DEPTH) ** 0.25
BETA = (8.0 * DEPTH) ** -0.25
NEG = -1e30

SPLIT_SIZES = (GLA_HEADS * GLA_DK, GLA_HEADS * GLA_DK, GLA_WIDTH, GLA_GATE_RANK, GLA_WIDTH,
               NSA_WIDTH, NSA_KV * NSA_HD, NSA_KV * NSA_HD, NSA_KV * NSA_HD, NSA_KV * NSA_HD,
               NSA_KV * NSA_HD, NSA_KV * NSA_HD, NSA_HEADS * 3)
SPLIT_IS_VALUE = (False, False, True, False, False, False, False, True, False, True, False, True, False)
IN_WIDTH = sum(SPLIT_SIZES)
SPLIT_POINTS = tuple(int(p) for p in np.cumsum(SPLIT_SIZES)[:-1])

kernel_name = 'gla_nsa_hybrid_decode_step'


def layer_norm(x, g, b):
    xf = x.astype(jnp.float32)
    mu = jnp.mean(xf, -1, keepdims=True)
    var = jnp.mean(jnp.square(xf - mu), -1, keepdims=True)
    return ((xf - mu) * lax.rsqrt(var + LN_EPS) * g + b).astype(x.dtype)


def head_rms_norm(o, g):
    of = o.astype(jnp.float32)
    return of * lax.rsqrt(jnp.mean(of * of, -1, keepdims=True) + LN_EPS) * g


def swiglu(x, w_in, w_out):
    gate, up = jnp.split(x @ w_in, 2, axis=-1)
    return (jax.nn.silu(gate) * up) @ w_out


def rope(x, pos):
    half = x.shape[-1] // 2
    freq = ROPE_THETA ** (-jnp.arange(half, dtype=jnp.float32) / half)
    ang = pos.astype(jnp.float32)[:, None] * freq[None, :]
    cos = jnp.cos(ang)[None, :, None, :]
    sin = jnp.sin(ang)[None, :, None, :]
    x1 = x[..., :half].astype(jnp.float32)
    x2 = x[..., half:].astype(jnp.float32)
    return jnp.concatenate([x1 * cos - x2 * sin, x2 * cos + x1 * sin], -1).astype(x.dtype)


def gla_chunked(q, k, v, log_a, s0):
    B, T, H, DK = q.shape
    DV = v.shape[-1]
    C = math.gcd(T, GLA_CHUNK)
    n = T // C
    f32 = jnp.float32

    def to_chunks(a):
        return a.astype(f32).reshape(B, n, C, H, a.shape[-1]).transpose(1, 0, 3, 2, 4)

    xs = (to_chunks(q * (DK ** -0.5)), to_chunks(k), to_chunks(v), to_chunks(log_a))
    causal = jnp.tril(jnp.ones((C, C), bool))[None, None, :, :, None]

    def step(S, inp):
        qi, ki, vi, ai = inp
        b = jnp.cumsum(ai, axis=2)
        diff = b[:, :, :, None, :] - b[:, :, None, :, :]
        decay = jnp.exp(jnp.where(causal, diff, -jnp.inf))
        attn = jnp.einsum('bhik,bhijk,bhjk->bhij', qi, decay, ki)
        o = jnp.einsum('bhij,bhjv->bhiv', attn, vi) + jnp.einsum('bhik,bhkv->bhiv', qi * jnp.exp(b), S)
        b_last = b[:, :, -1:, :]
        S_new = jnp.exp(b_last[:, :, 0, :])[..., None] * S + jnp.einsum('bhjk,bhjv->bhkv', ki * jnp.exp(b_last - b), vi)
        return S_new, o

    S_fin, o = lax.scan(step, s0.astype(f32), xs)
    o = o.transpose(1, 0, 3, 2, 4).reshape(B, T, H, DV)
    return o, S_fin.astype(s0.dtype)


def compress(rows, pos_emb, w1, w2):
    B, L, KV, HD = rows.shape
    n_cmp = (L - CMP_LEN) // CMP_STRIDE + 1
    idx = np.arange(n_cmp)[:, None] * CMP_STRIDE + np.arange(CMP_LEN)[None, :]
    blocks = rows[:, idx] + pos_emb[:, None, :].astype(rows.dtype)
    flat = blocks.transpose(0, 1, 3, 2, 4).reshape(B, n_cmp, KV, CMP_LEN * HD)
    return jax.nn.gelu(flat @ w1) @ w2


def cmp_attention(q, kc, vc, qpos):
    N = kc.shape[1]
    s = jnp.einsum('btkgd,bnkd->btkgn', q, kc).astype(jnp.float32) * (NSA_HD ** -0.5)
    end = jnp.asarray(np.arange(N) * CMP_STRIDE + CMP_LEN - 1)
    valid = (end[None, :] <= qpos[:, None])[None, :, None, None, :]
    p = jax.nn.softmax(jnp.where(valid, s, NEG), axis=-1) * valid
    o = jnp.einsum('btkgn,bnkd->btkgd', p.astype(vc.dtype), vc)
    return o, p


def select_blocks(p_cmp, qpos, n_sel):
    N = p_cmp.shape[-1]
    cs = np.arange(N) * CMP_STRIDE
    ss = np.arange(n_sel) * SEL_LEN
    overlap = ((cs[:, None] < ss[None, :] + SEL_LEN) & (cs[:, None] + CMP_LEN > ss[None, :])).astype(np.float32)
    imp = jnp.einsum('btkgn,ns->btks', p_cmp, jnp.asarray(overlap))
    ssj = jnp.asarray(ss)[None, :]
    cur = (qpos[:, None] // SEL_LEN) * SEL_LEN
    start_ok = ssj <= qpos[:, None]
    forced = (ssj == 0) | (ssj == cur) | (ssj == cur - SEL_LEN)
    score = jnp.where(start_ok[None, :, None, :], jnp.where(forced[None, :, None, :], 1e9, imp), -1e9)
    val, idx = lax.top_k(score, min(SEL_TOPN, n_sel))
    return idx, val > -1e8


def sel_attention_item(q, qpos, idx, ok, kblk, vblk):
    Tq = q.shape[0]
    kv_ar = jnp.arange(NSA_KV)[None, :, None]
    kg = kblk[kv_ar, idx]
    vg = vblk[kv_ar, idx]
    s = jnp.einsum('tkgd,tkjsd->tkgjs', q, kg).astype(jnp.float32) * (NSA_HD ** -0.5)
    kpos = idx[..., None] * SEL_LEN + jnp.arange(SEL_LEN)
    valid = (ok[..., None] & (kpos <= qpos[:, None, None, None]))[:, :, None]
    s = jnp.where(valid, s, NEG)
    p = jax.nn.softmax(s.reshape(Tq, NSA_KV, NSA_GROUP, -1), axis=-1).reshape(s.shape)
    return jnp.einsum('tkgjs,tkjsd->tkgd', p.astype(vg.dtype), vg)


def sel_attention(q, qpos, idx, ok, k_rows, v_rows, n_sel):
    B, T = q.shape[:2]
    L = k_rows.shape[1]
    pad = n_sel * SEL_LEN - L

    def blocks(r):
        r = jnp.pad(r, ((0, 0), (0, pad), (0, 0), (0, 0)))
        return r.reshape(B, n_sel, SEL_LEN, NSA_KV, NSA_HD).transpose(0, 3, 1, 2, 4)

    kb, vb = blocks(k_rows), blocks(v_rows)
    qb = math.gcd(T, Q_BLOCK)
    nb = T // qb

    def items(a):
        return a.reshape(B * nb, qb, *a.shape[2:])

    b_id = jnp.repeat(jnp.arange(B), nb)
    qpos_items = jnp.tile(qpos.reshape(nb, qb), (B, 1))

    def fn(args):
        qi, pi, ii, oi, bi = args
        return sel_attention_item(qi, pi, ii, oi, kb[bi], vb[bi])

    o = lax.map(fn, (items(q), qpos_items, items(idx), items(ok), b_id))
    return o.reshape(B, T, NSA_KV, NSA_GROUP, NSA_HD)


def window_attention(q, qpos, k_full, v_full, kpos_full):
    B, T = q.shape[:2]
    qb = math.gcd(T, Q_BLOCK)
    nb = T // qb
    band = np.arange(nb)[:, None] * qb + np.arange(WINDOW + qb)[None, :]
    kb, vb, kp = k_full[:, band], v_full[:, band], kpos_full[band]
    qq = q.reshape(B, nb, qb, NSA_KV, NSA_GROUP, NSA_HD)
    qp = qpos.reshape(nb, qb)
    s = jnp.einsum('bnqkgd,bnskd->bnqkgs', qq, kb).astype(jnp.float32) * (NSA_HD ** -0.5)
    dist = qp[:, :, None] - kp[:, None, :]
    valid = ((kp[:, None, :] >= 0) & (dist >= 0) & (dist < WINDOW))[None, :, :, None, None, :]
    p = jax.nn.softmax(jnp.where(valid, s, NEG), axis=-1)
    o = jnp.einsum('bnqkgs,bnskd->bnqkgd', p.astype(vb.dtype), vb)
    return o.reshape(B, T, NSA_KV, NSA_GROUP, NSA_HD)


def token_mixing(h, qpos, past_cmp, past_slc, win_prefix, win_prefix_pos, gla_s0, w_buf,
                 w_in, w_gla_gate2, b_gla_gate2, gla_norm_g, cmp_pos, cmp_w1, cmp_w2, w_out):
    B, T, _ = h.shape
    f32 = jnp.float32
    (gq, gk, gv, ga, gr, nq, kc, vc, ks, vs, kw, vw, ng) = jnp.split(h @ w_in, SPLIT_POINTS, axis=-1)

    def heads(a, n):
        return a.reshape(B, T, n, -1)

    log_a = jax.nn.log_sigmoid((ga @ w_gla_gate2 + b_gla_gate2).astype(f32)) / GLA_TAU
    o_g, gla_s = gla_chunked(heads(gq, GLA_HEADS), heads(gk, GLA_HEADS), heads(gv, GLA_HEADS),
                             heads(log_a, GLA_HEADS), gla_s0)
    o_g = head_rms_norm(o_g, gla_norm_g) * jax.nn.silu(heads(gr, GLA_HEADS).astype(f32))

    q = rope(heads(nq, NSA_HEADS), qpos).reshape(B, T, NSA_KV, NSA_GROUP, NSA_HD)
    cmp_rows = jnp.stack([rope(heads(kc, NSA_KV), qpos), heads(vc, NSA_KV)], axis=2)
    slc_rows = jnp.stack([rope(heads(ks, NSA_KV), qpos), heads(vs, NSA_KV)], axis=2)
    win_rows = jnp.stack([rope(heads(kw, NSA_KV), qpos), heads(vw, NSA_KV)], axis=2)
    cmp_all = cmp_rows if past_cmp is None else jnp.concatenate([past_cmp, cmp_rows], axis=1)
    slc_all = slc_rows if past_slc is None else jnp.concatenate([past_slc, slc_rows], axis=1)

    k_cmp = compress(cmp_all[:, :, 0], cmp_pos[0], cmp_w1[0], cmp_w2[0])
    v_cmp = compress(cmp_all[:, :, 1], cmp_pos[1], cmp_w1[1], cmp_w2[1])
    o_c, p_c = cmp_attention(q, k_cmp, v_cmp, qpos)

    n_sel = -(-slc_all.shape[1] // SEL_LEN)
    idx, ok = select_blocks(p_c, qpos, n_sel)
    o_s = sel_attention(q, qpos, idx, ok, slc_all[:, :, 0], slc_all[:, :, 1], n_sel)

    win_all = jnp.concatenate([win_prefix.astype(win_rows.dtype), win_rows], axis=1)
    win_pos = jnp.concatenate([win_prefix_pos, qpos])
    o_w = window_attention(q, qpos, win_all[:, :, 0], win_all[:, :, 1], win_pos)

    g = jax.nn.sigmoid(ng.reshape(B, T, NSA_KV, NSA_GROUP, 3).astype(f32))
    o_n = g[..., 0:1] * o_c + g[..., 1:2] * o_s + g[..., 2:3] * o_w

    mix = jnp.concatenate([o_g.reshape(B, T, GLA_WIDTH), o_n.reshape(B, T, NSA_WIDTH)], axis=-1).astype(h.dtype)
    return mix @ w_out, cmp_rows, slc_rows, win_all[:, -w_buf:], gla_s


def decoder_layer(x, qpos, past_cmp, past_slc, win_prefix, win_prefix_pos, gla_s0, w_buf,
                  w_ffn1_in, w_ffn1_out, w_in, w_gla_gate2, b_gla_gate2, gla_norm_g,
                  cmp_pos, cmp_w1, cmp_w2, w_out, w_ffn2_in, w_ffn2_out, ln_g, ln_b):
    x = layer_norm(ALPHA * x + 0.5 * swiglu(x, w_ffn1_in, w_ffn1_out), ln_g[0], ln_b[0])
    m, cmp_rows, slc_rows, win_buf, gla_s = token_mixing(
        x, qpos, past_cmp, past_slc, win_prefix, win_prefix_pos, gla_s0, w_buf,
        w_in, w_gla_gate2, b_gla_gate2, gla_norm_g, cmp_pos, cmp_w1, cmp_w2, w_out)
    x = layer_norm(ALPHA * x + m, ln_g[1], ln_b[1])
    x = layer_norm(ALPHA * x + 0.5 * swiglu(x, w_ffn2_in, w_ffn2_out), ln_g[2], ln_b[2])
    return x, cmp_rows, slc_rows, win_buf, gla_s


def gather_pages(pool, page_table):
    db, n_pages = page_table.shape
    return pool[page_table].reshape(db, n_pages * PAGE_SIZE, *pool.shape[2:])


def setup_inputs(seed: int = 0) -> dict:
    key = jax.random.key(seed)
    k = jax.random.split(key, 24)
    f32 = jnp.float32
    n_pages = PAST_LEN // PAGE_SIZE
    n_pool = (DEC_BATCH * n_pages * 5) // 4
    w_buf = min(WINDOW, PAST_LEN)

    def nrm(kk, shape, scale):
        return jax.random.normal(kk, shape, f32) * scale

    col_scale = jnp.asarray(np.concatenate(
        [np.full((n,), BETA if is_v else 1.0, np.float32) for n, is_v in zip(SPLIT_SIZES, SPLIT_IS_VALUE)]))
    page_table = jax.random.permutation(k[6], n_pool)[: DEC_BATCH * n_pages].reshape(DEC_BATCH, n_pages).astype(jnp.int32)
    return {
        'x_prompt': nrm(k[0], (BATCH, SEQ, D_MODEL), 1.0),
        'x_sample': nrm(k[1], (DEC_BATCH, DEC_SEQ, D_MODEL), 1.0),
        'cache_cmp_kv': nrm(k[2], (DEPTH, n_pool, PAGE_SIZE, 2, NSA_KV, NSA_HD), 1.0),
        'cache_slc_kv': nrm(k[3], (DEPTH, n_pool, PAGE_SIZE, 2, NSA_KV, NSA_HD), 1.0),
        'cache_win_kv': nrm(k[4], (DEPTH, DEC_BATCH, w_buf, 2, NSA_KV, NSA_HD), 1.0),
        'state_gla': nrm(k[5], (DEPTH, DEC_BATCH, GLA_HEADS, GLA_DK, GLA_DV), 0.5),
        'page_table': page_table,
        'w_ffn1_in': nrm(k[7], (DEPTH, D_MODEL, 2 * D_FF), BETA * D_MODEL ** -0.5),
        'w_ffn1_out': nrm(k[8], (DEPTH, D_FF, D_MODEL), BETA * D_FF ** -0.5),
        'w_in': nrm(k[9], (DEPTH, D_MODEL, IN_WIDTH), D_MODEL ** -0.5) * col_scale,
        'w_gla_gate2': nrm(k[10], (DEPTH, GLA_GATE_RANK, GLA_HEADS * GLA_DK), GLA_GATE_RANK ** -0.5),
        'b_gla_gate2': nrm(k[11], (DEPTH, GLA_HEADS * GLA_DK), 0.1),
        'gla_norm_g': 1.0 + nrm(k[12], (DEPTH, GLA_DV), 0.01),
        'cmp_pos': nrm(k[13], (DEPTH, 2, CMP_LEN, NSA_HD), 0.02),
        'cmp_w1': nrm(k[14], (DEPTH, 2, CMP_LEN * NSA_HD, CMP_HIDDEN), (CMP_LEN * NSA_HD) ** -0.5),
        'cmp_w2': nrm(k[15], (DEPTH, 2, CMP_HIDDEN, NSA_HD), CMP_HIDDEN ** -0.5),
        'w_out': nrm(k[16], (DEPTH, MIX_WIDTH, D_MODEL), BETA * MIX_WIDTH ** -0.5),
        'w_ffn2_in': nrm(k[17], (DEPTH, D_MODEL, 2 * D_FF), BETA * D_MODEL ** -0.5),
        'w_ffn2_out': nrm(k[18], (DEPTH, D_FF, D_MODEL), BETA * D_FF ** -0.5),
        'ln_g': 1.0 + nrm(k[19], (DEPTH, 3, D_MODEL), 0.01),
        'ln_b': nrm(k[20], (DEPTH, 3, D_MODEL), 0.01),
    }


def reference(x_prompt, x_sample, cache_cmp_kv, cache_slc_kv, cache_win_kv, state_gla, page_table,
              w_ffn1_in, w_ffn1_out, w_in, w_gla_gate2, b_gla_gate2, gla_norm_g,
              cmp_pos, cmp_w1, cmp_w2, w_out, w_ffn2_in, w_ffn2_out, ln_g, ln_b):
    B, T = x_prompt.shape[:2]
    DB, TS = x_sample.shape[:2]
    past_len = page_table.shape[1] * PAGE_SIZE
    w_buf = cache_win_kv.shape[2]
    qpos_p = jnp.arange(T, dtype=jnp.int32)
    qpos_s = past_len + jnp.arange(TS, dtype=jnp.int32)
    pref_pos_p = jnp.arange(-WINDOW, 0, dtype=jnp.int32)
    pref_pos_s = jnp.concatenate([jnp.full((WINDOW - w_buf,), -1, jnp.int32),
                                  past_len - w_buf + jnp.arange(w_buf, dtype=jnp.int32)])
    win_pref_p = jnp.zeros((B, WINDOW, 2, NSA_KV, NSA_HD), x_prompt.dtype)
    gla_zero = jnp.zeros((B, GLA_HEADS, GLA_DK, GLA_DV), x_prompt.dtype)

    hp, hs = x_prompt, x_sample
    cmp_p, slc_p, win_p, gla_p = [], [], [], []
    cmp_s, slc_s, win_s, gla_s = [], [], [], []
    for l in range(DEPTH):
        weights = (w_ffn1_in[l], w_ffn1_out[l], w_in[l], w_gla_gate2[l], b_gla_gate2[l], gla_norm_g[l],
                   cmp_pos[l], cmp_w1[l], cmp_w2[l], w_out[l], w_ffn2_in[l], w_ffn2_out[l], ln_g[l], ln_b[l])
        hp, c_r, s_r, w_b, g_s = decoder_layer(hp, qpos_p, None, None, win_pref_p, pref_pos_p, gla_zero, w_buf, *weights)
        cmp_p.append(c_r); slc_p.append(s_r); win_p.append(w_b); gla_p.append(g_s)
        past_cmp = gather_pages(cache_cmp_kv[l], page_table)
        past_slc = gather_pages(cache_slc_kv[l], page_table)
        win_pref_s = jnp.pad(cache_win_kv[l], ((0, 0), (WINDOW - w_buf, 0), (0, 0), (0, 0), (0, 0)))
        hs, c_r, s_r, w_b, g_s = decoder_layer(hs, qpos_s, past_cmp, past_slc, win_pref_s, pref_pos_s, state_gla[l], w_buf, *weights)
        cmp_s.append(c_r); slc_s.append(s_r); win_s.append(w_b); gla_s.append(g_s)

    return (hp, hs,
            jnp.stack(cmp_p), jnp.stack(slc_p), jnp.stack(win_p), jnp.stack(gla_p),
            jnp.stack(cmp_s), jnp.stack(slc_s), jnp.stack(win_s), jnp.stack(gla_s))
```

```cpp
#include <hip/hip_runtime.h>
#include <cstdio>
#include <cstdint>
namespace pg8 {
#define PG8_LAS __attribute__((address_space(3)))
typedef unsigned short bf16_t;
typedef short bf16x8 __attribute__((ext_vector_type(8)));
typedef float f32x4 __attribute__((ext_vector_type(4)));
typedef unsigned u32x4 __attribute__((ext_vector_type(4)));
constexpr int BM = 256, BK = 64, HALF = 128, HTB = HALF * BK * 2  , STAGE_BYTES = 8 * HTB, NXCD = 8, WGM = 8;

__host__ __device__ __forceinline__ int lds_byte(int r, int c) { const int st = (r >> 4) * 2 + (c >> 5), rr = r & 15, cc = c & 31, ob = rr * 64 + cc * 2; return st * 1024 + (ob ^ (((ob >> 9) & 1) << 5)); }
__host__ __device__ __forceinline__ void stage_rc(int b, int& R, int& C) { const int st = b / 1024, sb = b % 1024, swz = sb ^ (((sb >> 9) & 1) << 5); R = (st >> 1) * 16 + swz / 64; C = (st & 1) * 32 + (swz % 64) / 2; }
__host__ __device__ __forceinline__ int perm32(int rho) { const int n = rho >> 4, i = rho & 15; return 8 * (i >> 2) + 4 * n + (i & 3); }

struct Unit { int pm, pn, kb; };
struct Gemm { const bf16_t* A; const bf16_t* Bt; int M, N, K, ld; };

struct StaticOrder {
    int nM, nN, nwg, G, c;
    __host__ __device__ void init(int M, int N, int G_, int c_) { nM = M / BM; nN = N / BM; nwg = nM * nN; G = G_; c = c_; }
    __host__ __device__ bool next(int i, Unit& u) const {
        const long L = (long)i * G + c; if (L >= nwg) return false;
        int wgid = (int)L; { const int q = nwg / NXCD, r = nwg % NXCD, xcd = wgid % NXCD, off = wgid / NXCD; wgid = (xcd < r ? xcd * (q + 1) : r * (q + 1) + (xcd - r) * q) + off; }
        const int nig = WGM * nN, gid = wgid / nig, fm = gid * WGM, gsz = (nM - fm) < WGM ? (nM - fm) : WGM;
        u.pm = fm + ((wgid % nig) % gsz); u.pn = (wgid % nig) / gsz; u.kb = 0; return true;
    }
    __device__ __forceinline__ void a_ready(const Unit&) const {}
    __device__ __forceinline__ void done(const Unit&) const {}
};
template <class Epi, class Sched, bool ALIGN_EPI = false, bool SP2 = false>
__device__ __forceinline__ void gemm_phase(PG8_LAS unsigned char* lds, const Gemm g, const Sched& S, const Epi& E) {
    int tid_ = threadIdx.x; asm volatile("" : "+v"(tid_));
    const int tid = tid_, wid = __builtin_amdgcn_readfirstlane(tid >> 6), lane = tid & 63, wr = wid >> 2, wc = wid & 3, fr = lane & 15, fq = lane >> 4;
    const int K = g.K, nt = K / BK, LD = g.ld ? g.ld : g.K;
    unsigned voffA[2], voffB[2];
#pragma unroll
    for (int i = 0; i < 2; ++i) { int R, C; stage_rc(tid * 16 + i * 8192, R, C); const int Rb = Epi::PERM ? ((R & ~31) + perm32(R & 31)) : R;
        voffA[i] = (unsigned)(R * LD + C) * 2u; voffB[i] = (unsigned)(Rb * LD + C) * 2u; }
    const size_t kstep = (size_t)(BK * 2);
    const size_t hstep = (size_t)HALF * LD * 2;
    const size_t tstep = 2 * hstep;
    const unsigned ldsw = (unsigned)wid * 1024u;
    const int aoff = lds_byte(wr * 64 + fr, fq * 8), boff = lds_byte(wc * 32 + fr, fq * 8);
#define PG8_SA(b, h) (((b) * 2 + (h)) * HTB)
#define PG8_SB(b, h) ((4 + (b) * 2 + (h)) * HTB)
#define PG8_STAGE(bufoff, gbase, voff) do { _Pragma("unroll") for (int _i = 0; _i < 2; ++_i) \
        __builtin_amdgcn_global_load_lds((const unsigned*)((const char*)(gbase) + (voff)[_i]), (PG8_LAS unsigned*)(lds + (bufoff) + ldsw + _i * 8192), 16, 0, 0); } while (0)
#define PG8_LDA(dst, b, h) do { _Pragma("unroll") for (int m = 0; m < 4; ++m) _Pragma("unroll") for (int k = 0; k < 2; ++k) dst[m][k] = *(const PG8_LAS bf16x8*)(lds + PG8_SA(b, h) + aoff + m * 2048 + k * 1024); } while (0)
#define PG8_LDB(dst, b, h) do { _Pragma("unroll") for (int n = 0; n < 2; ++n) _Pragma("unroll") for (int k = 0; k < 2; ++k) dst[n][k] = *(const PG8_LAS bf16x8*)(lds + PG8_SB(b, h) + boff + n * 2048 + k * 1024); } while (0)
#define PG8_MMA(ai, bj, At, Bt) do { __builtin_amdgcn_s_setprio(1); _Pragma("unroll") for (int m = 0; m < 4; ++m) _Pragma("unroll") for (int n = 0; n < 2; ++n) _Pragma("unroll") for (int k = 0; k < 2; ++k) \
        acc[ai][bj][m][n] = __builtin_amdgcn_mfma_f32_16x16x32_bf16(Bt[n][k], At[m][k], acc[ai][bj][m][n], 0, 0, 0); __builtin_amdgcn_s_setprio(0); } while (0)
#define PG8_WAIT_V(n) asm volatile("s_waitcnt vmcnt(" #n ")" ::: "memory")
#define PG8_WAIT_L(n) asm volatile("s_waitcnt lgkmcnt(" #n ")" ::: "memory")
#define PG8_BAR __builtin_amdgcn_s_barrier()
#define PG8_SCHED __builtin_amdgcn_sched_barrier(0)
    Unit cur, nxt; int ui = 0;
    if (!S.next(0, cur)) return;
    f32x4 acc[2][2][4][2];
#pragma unroll
    for (int a = 0; a < 2; ++a)
#pragma unroll
        for (int b = 0; b < 2; ++b)
#pragma unroll
            for (int m = 0; m < 4; ++m)
#pragma unroll
                for (int n = 0; n < 2; ++n) acc[a][b][m][n] = (f32x4){0.f, 0.f, 0.f, 0.f};
    bf16x8 At[4][2], B0[2][2], B1[2][2];
    const char* cA = (const char*)g.A + (size_t)cur.pm * tstep + cur.kb; const char* cB = (const char*)g.Bt + (size_t)cur.pn * tstep + cur.kb;
    S.a_ready(cur);
    if constexpr (SP2) {
        PG8_STAGE(PG8_SB(0, 0), cB, voffB); PG8_STAGE(PG8_SB(0, 1), cB + hstep, voffB); PG8_STAGE(PG8_SA(0, 0), cA, voffA); PG8_STAGE(PG8_SA(0, 1), cA + hstep, voffA);
        if (wr == 1) PG8_BAR;
        PG8_WAIT_V(2); PG8_BAR;
        PG8_STAGE(PG8_SB(1, 0), cB + kstep, voffB); PG8_STAGE(PG8_SA(1, 0), cA + kstep, voffA); PG8_STAGE(PG8_SB(1, 1), cB + hstep + kstep, voffB);
        PG8_WAIT_V(6); PG8_BAR;
    } else {
        PG8_STAGE(PG8_SB(0, 0), cB, voffB); PG8_STAGE(PG8_SA(0, 0), cA, voffA); PG8_STAGE(PG8_SB(0, 1), cB + hstep, voffB); PG8_STAGE(PG8_SA(0, 1), cA + hstep, voffA);
        if (wr == 1) PG8_BAR;
        PG8_WAIT_V(4); PG8_BAR;
        PG8_STAGE(PG8_SB(1, 0), cB + kstep, voffB); PG8_STAGE(PG8_SA(1, 0), cA + kstep, voffA); PG8_STAGE(PG8_SB(1, 1), cB + hstep + kstep, voffB);
        PG8_WAIT_V(6); PG8_BAR;
    }
    for (;;) {
        const bool has_next = S.next(ui + 1, nxt);
        const char* nA = has_next ? (const char*)g.A + (size_t)nxt.pm * tstep + nxt.kb : cA; const char* nB = has_next ? (const char*)g.Bt + (size_t)nxt.pn * tstep + nxt.kb : cB;
        for (int t = 0; t < nt; t += 2) {
            const bool last = (t == nt - 2);
            const char* a1 = cA + (size_t)(t + 1) * kstep;
            const char* a2 = last ? nA : cA + (size_t)(t + 2) * kstep; const char* b2 = last ? nB : cB + (size_t)(t + 2) * kstep;
            const char* a3 = a2 + kstep; const char* b3 = b2 + kstep;
            if (last && has_next) S.a_ready(nxt);
            if constexpr (SP2) {
            PG8_LDB(B0, 0, 0); PG8_LDB(B1, 0, 1); PG8_SCHED; PG8_LDA(At, 0, 0); PG8_STAGE(PG8_SA(1, 1), a1 + hstep, voffA);
            PG8_WAIT_V(8); PG8_WAIT_L(0); PG8_BAR; PG8_MMA(0, 0, At, B0); PG8_MMA(0, 1, At, B1); PG8_BAR; PG8_SCHED;
            PG8_LDA(At, 0, 1); PG8_STAGE(PG8_SB(0, 0), b2, voffB); PG8_STAGE(PG8_SB(0, 1), b2 + hstep, voffB); PG8_STAGE(PG8_SA(0, 0), a2, voffA);
            PG8_WAIT_V(8); PG8_WAIT_L(0); PG8_BAR; PG8_MMA(1, 0, At, B0); PG8_MMA(1, 1, At, B1); PG8_BAR; PG8_SCHED;
            PG8_LDB(B0, 1, 0); PG8_LDB(B1, 1, 1); PG8_SCHED; PG8_LDA(At, 1, 0); PG8_STAGE(PG8_SA(0, 1), a2 + hstep, voffA);
            PG8_WAIT_V(8); PG8_WAIT_L(0); PG8_BAR; PG8_MMA(0, 0, At, B0); PG8_MMA(0, 1, At, B1); PG8_BAR; PG8_SCHED;
            PG8_LDA(At, 1, 1); PG8_STAGE(PG8_SB(1, 0), b3, voffB); PG8_STAGE(PG8_SB(1, 1), b3 + hstep, voffB); PG8_STAGE(PG8_SA(1, 0), a3, voffA);
            PG8_WAIT_V(8); PG8_WAIT_L(0); PG8_BAR; PG8_MMA(1, 0, At, B0); PG8_MMA(1, 1, At, B1); PG8_BAR; PG8_SCHED;
            } else {
            PG8_LDB(B0, 0, 0); PG8_SCHED; PG8_LDA(At, 0, 0); PG8_STAGE(PG8_SA(1, 1), a1 + hstep, voffA);
            PG8_WAIT_L(8); PG8_BAR; PG8_WAIT_L(0); PG8_MMA(0, 0, At, B0); PG8_BAR; PG8_SCHED;
            PG8_LDB(B1, 0, 1); PG8_STAGE(PG8_SB(0, 0), b2, voffB);
            PG8_BAR; PG8_WAIT_L(0); PG8_MMA(0, 1, At, B1); PG8_BAR;
            PG8_LDA(At, 0, 1); PG8_STAGE(PG8_SA(0, 0), a2, voffA);
            PG8_BAR; PG8_WAIT_L(0); PG8_MMA(1, 0, At, B0); PG8_BAR; PG8_SCHED;
            PG8_STAGE(PG8_SB(0, 1), b2 + hstep, voffB);
            PG8_WAIT_V(6); PG8_BAR; PG8_MMA(1, 1, At, B1); PG8_BAR;
            PG8_LDB(B0, 1, 0); PG8_SCHED; PG8_LDA(At, 1, 0); PG8_STAGE(PG8_SA(0, 1), a2 + hstep, voffA);
            PG8_WAIT_L(8); PG8_BAR; PG8_WAIT_L(0); PG8_MMA(0, 0, At, B0); PG8_BAR; PG8_SCHED;
            PG8_LDB(B1, 1, 1); PG8_STAGE(PG8_SB(1, 0), b3, voffB);
            PG8_BAR; PG8_WAIT_L(0); PG8_MMA(0, 1, At, B1); PG8_BAR;
            PG8_LDA(At, 1, 1); PG8_STAGE(PG8_SA(1, 0), a3, voffA);
            PG8_BAR; PG8_WAIT_L(0); PG8_MMA(1, 0, At, B0); PG8_BAR; PG8_SCHED;
            PG8_STAGE(PG8_SB(1, 1), b3 + hstep, voffB);
            PG8_WAIT_V(6); PG8_BAR; PG8_MMA(1, 1, At, B1); PG8_BAR;
            }
        }
        if constexpr (ALIGN_EPI) { if (wr == 0) PG8_BAR; }
        if constexpr (!Epi::AFTER_DRAIN) { E(acc, cur, wr, wc, fr, fq); S.done(cur); }
        if (!has_next) break;
#pragma unroll
        for (int a = 0; a < 2; ++a)
#pragma unroll
            for (int b = 0; b < 2; ++b)
#pragma unroll
                for (int m = 0; m < 4; ++m)
#pragma unroll
                    for (int n = 0; n < 2; ++n) acc[a][b][m][n] = (f32x4){0.f, 0.f, 0.f, 0.f};
        cur = nxt; cA = nA; cB = nB; ++ui;
        if constexpr (ALIGN_EPI) { if (wr == 1) PG8_BAR; }
    }
    PG8_WAIT_V(0);
    if constexpr (!ALIGN_EPI) { if (wr == 0) PG8_BAR; }
    PG8_BAR;
    if constexpr (Epi::AFTER_DRAIN) { E.fused(acc, cur, wr, wc, fr, fq, lds, wid, lane); S.done(cur); }
#undef PG8_SA
#undef PG8_SB
#undef PG8_STAGE
#undef PG8_LDA
#undef PG8_LDB
#undef PG8_MMA
#undef PG8_WAIT_V
#undef PG8_WAIT_L
#undef PG8_BAR
#undef PG8_SCHED
}
}

constexpr int DM = 2048, NB = 8, TT = 2048, NDB = 128, NTS = 8, DFF = 5632;
constexpr int MP = NB * TT, MS = NDB * NTS, MTOT = MP + MS;
constexpr int NSEQ = NDB + NB;
constexpr int NIN = 5632, NEXTRA = 64;
constexpr int GLAW = 3072;
constexpr int XROWS = NSEQ * 4 * 128;
constexpr float LN_EPS = 1e-5f, ALPHA = 1.189207115002721f, LOG2E = 1.4426950408889634f;
constexpr int NWAVES = 8;

constexpr size_t O_YP = 0, O_YS = 33554432, O_CMPP = 35651584, O_SLCP = 44040192, O_WINP = 52428800, O_GLAP = 54525952,
                 O_CMPS = 55574528, O_SLCS = 56098816, O_WINS = 56623104, O_GLAS = 90177536, O_END = 106954752;

constexpr size_t MiB = 1u << 20;
constexpr size_t WS_CTL = 0, CTL_ZERO_BYTES = 64 * 1024;
constexpr size_t WS_SMALL = 1 * MiB;
constexpr size_t WS_W1A = 2 * MiB;
constexpr size_t WS_W1B = WS_W1A + 44 * MiB;
constexpr size_t WS_WIN = WS_W1B + 22 * MiB;
constexpr size_t WS_WOUT = WS_WIN + 23 * MiB;
constexpr size_t WS_W2A = WS_WOUT + 8 * MiB;
constexpr size_t WS_W2B = WS_W2A + 44 * MiB;
constexpr size_t WS_CW1 = WS_W2B + 22 * MiB;
constexpr size_t WS_XB = WS_CW1 + 1 * MiB;
constexpr size_t WS_HB = WS_XB + 68 * MiB;
constexpr size_t WS_ZF = WS_HB + 187 * MiB;
constexpr size_t WS_GLAIN = WS_ZF + 136 * MiB;
constexpr size_t WS_NQ = WS_GLAIN + 204 * MiB;
constexpr size_t WS_EXTRA = WS_NQ + 34 * MiB;
constexpr size_t WS_WINROWS = WS_EXTRA + 5 * MiB;
constexpr size_t WS_ORAW = WS_WINROWS + 32 * MiB;
constexpr size_t WS_MIX = WS_ORAW + 64 * MiB;
constexpr size_t WS_XBLK = WS_MIX + 68 * MiB;
constexpr size_t WS_ZC = WS_XBLK + 272 * MiB;
constexpr size_t WS_KCMP = WS_ZC + 136 * MiB;
constexpr size_t WS_GQ = WS_KCMP + 34 * MiB;
constexpr size_t WS_GKT = WS_GQ + 16 * MiB;
constexpr size_t WS_GA = WS_GKT + 16 * MiB;
constexpr size_t WS_GVT = WS_GA + 8 * MiB;
constexpr size_t WS_GD = WS_GVT + 32 * MiB;
constexpr size_t WS_SLAB = WS_GD + 1 * MiB;
constexpr size_t WS_KB16 = WS_SLAB + 32 * MiB;
constexpr size_t WS_VT16 = WS_KB16 + 16 * MiB;
constexpr size_t WS_KC16 = WS_VT16 + 16 * MiB;
constexpr size_t WS_VCT16 = WS_KC16 + 9 * MiB;
constexpr size_t WS_END = WS_VCT16 + 9 * MiB;
constexpr int CW_TMO = 0, CW_CODE = 1, CW_BAR = 4096;

constexpr int RING_BYTES = 131072;
constexpr int LDSCTL_OFF = RING_BYTES, MISC_OFF = LDSCTL_OFF + 320;
constexpr int LDS_BYTES = 147456;

#define GAS __attribute__((address_space(1)))
#define LAS __attribute__((address_space(3)))
typedef unsigned short bf16;
typedef float f32x2 __attribute__((ext_vector_type(2)));
typedef float f32x4 __attribute__((ext_vector_type(4)));
typedef float f32x16 __attribute__((ext_vector_type(16)));
typedef short bf16x8 __attribute__((ext_vector_type(8)));
typedef short s16x4 __attribute__((ext_vector_type(4)));
typedef unsigned u32x2 __attribute__((ext_vector_type(2)));
typedef unsigned u32x4 __attribute__((ext_vector_type(4)));
typedef __bf16 bf16x2_t __attribute__((ext_vector_type(2)));
typedef GAS unsigned gu32;
#define RLX_AGENT __ATOMIC_RELAXED, __HIP_MEMORY_SCOPE_AGENT
#define LDS_WAIT() asm volatile("s_waitcnt lgkmcnt(0)" ::: "memory")
#define VM_WAIT() asm volatile("s_waitcnt vmcnt(0)" ::: "memory")
#define DI __device__ __forceinline__

DI unsigned pk2(float lo, float hi) { f32x2 v = {lo, hi}; bf16x2_t b = __builtin_convertvector(v, bf16x2_t); return __builtin_bit_cast(unsigned, b); }
DI float wave_sum(float v) {
#pragma unroll
    for (int o = 1; o < 64; o <<= 1) v += __shfl_xor(v, o);
    return v;
}
DI float fexp2(float x) { return __builtin_amdgcn_exp2f(x); }
DI float frcp(float x) { return __builtin_amdgcn_rcpf(x); }
DI float sigmoidf_(float x) { return frcp(1.f + fexp2(-x * LOG2E)); }
DI float siluf_(float x) { return x * sigmoidf_(x); }


struct EpiSwiGLU {
    static constexpr bool PERM = true, AFTER_DRAIN = false;
    bf16* H;
    DI void operator()(const f32x4 (&acc)[2][2][4][2], const pg8::Unit& u, int wr, int wc, int fr, int fq) const {
        const int row0 = u.pm * 256 + wr * 64 + fr, col0 = u.pn * 128 + wc * 32 + 8 * fq;
#pragma unroll
        for (int ai = 0; ai < 2; ++ai)
#pragma unroll
            for (int m = 0; m < 4; ++m) {
                const f32x4 g0 = acc[ai][0][m][0], g1 = acc[ai][0][m][1], u0 = acc[ai][1][m][0], u1 = acc[ai][1][m][1];
                u32x4 w;
                w.x = pk2(siluf_(g0[0]) * u0[0], siluf_(g0[1]) * u0[1]); w.y = pk2(siluf_(g0[2]) * u0[2], siluf_(g0[3]) * u0[3]);
                w.z = pk2(siluf_(g1[0]) * u1[0], siluf_(g1[1]) * u1[1]); w.w = pk2(siluf_(g1[2]) * u1[2], siluf_(g1[3]) * u1[3]);
                *(u32x4*)(H + (size_t)(row0 + ai * 128 + m * 16) * DFF + col0) = w;
            }
    }
};

DI f32x4 bf4_lo(u32x4 q) { return (f32x4){__builtin_bit_cast(float, q.x << 16), __builtin_bit_cast(float, q.x & 0xffff0000u), __builtin_bit_cast(float, q.y << 16), __builtin_bit_cast(float, q.y & 0xffff0000u)}; }
DI f32x4 bf4_hi(u32x4 q) { return (f32x4){__builtin_bit_cast(float, q.z << 16), __builtin_bit_cast(float, q.z & 0xffff0000u), __builtin_bit_cast(float, q.w << 16), __builtin_bit_cast(float, q.w & 0xffff0000u)}; }
struct EpiResid {
    static constexpr bool PERM = true, AFTER_DRAIN = false;
    const float* res; bf16* out; float sc;
    DI void operator()(const f32x4 (&acc)[2][2][4][2], const pg8::Unit& u, int wr, int wc, int fr, int fq) const {
        const int row0 = u.pm * 256 + wr * 64 + fr, col0 = u.pn * 256 + wc * 32 + 8 * fq;
#pragma unroll
        for (int ai = 0; ai < 2; ++ai) {
            f32x4 r[4][2][2];
#pragma unroll
            for (int m = 0; m < 4; ++m)
#pragma unroll
                for (int bj = 0; bj < 2; ++bj)
#pragma unroll
                    for (int n = 0; n < 2; ++n) r[m][bj][n] = __builtin_nontemporal_load((const f32x4*)(res + (size_t)(row0 + ai * 128 + m * 16) * DM + col0 + bj * 128 + n * 4));
            asm volatile("" ::: "memory");
#pragma unroll
            for (int m = 0; m < 4; ++m)
#pragma unroll
                for (int bj = 0; bj < 2; ++bj) { const f32x4 a = r[m][bj][0] * ALPHA + acc[ai][bj][m][0] * sc, b = r[m][bj][1] * ALPHA + acc[ai][bj][m][1] * sc;
                    *(u32x4*)(out + (size_t)(row0 + ai * 128 + m * 16) * DM + col0 + bj * 128) = (u32x4){pk2(a[0], a[1]), pk2(a[2], a[3]), pk2(b[0], b[1]), pk2(b[2], b[3])}; }
        }
    }
};
struct EpiResid16 {
    static constexpr bool PERM = true, AFTER_DRAIN = false;
    const bf16* res; bf16* out; float sc;
    DI void operator()(const f32x4 (&acc)[2][2][4][2], const pg8::Unit& u, int wr, int wc, int fr, int fq) const {
        const int row0 = u.pm * 256 + wr * 64 + fr, col0 = u.pn * 256 + wc * 32 + 8 * fq;
#pragma unroll
        for (int ai = 0; ai < 2; ++ai) {
            u32x4 r[4][2];
#pragma unroll
            for (int m = 0; m < 4; ++m)
#pragma unroll
                for (int bj = 0; bj < 2; ++bj) r[m][bj] = *(const u32x4*)(res + (size_t)(row0 + ai * 128 + m * 16) * DM + col0 + bj * 128);
            asm volatile("" ::: "memory");
#pragma unroll
            for (int m = 0; m < 4; ++m)
#pragma unroll
                for (int bj = 0; bj < 2; ++bj) { const f32x4 a = bf4_lo(r[m][bj]) * ALPHA + acc[ai][bj][m][0] * sc, b = bf4_hi(r[m][bj]) * ALPHA + acc[ai][bj][m][1] * sc;
                    *(u32x4*)(out + (size_t)(row0 + ai * 128 + m * 16) * DM + col0 + bj * 128) = (u32x4){pk2(a[0], a[1]), pk2(a[2], a[3]), pk2(b[0], b[1]), pk2(b[2], b[3])}; }
        }
    }
};

struct EpiZ {
    static constexpr bool PERM = true, AFTER_DRAIN = false;
    bf16* Z;
    DI void operator()(const f32x4 (&acc)[2][2][4][2], const pg8::Unit& u, int wr, int wc, int fr, int fq) const {
        const int row0 = u.pm * 256 + wr * 64 + fr, col0 = wc * 32 + 8 * fq;
#pragma unroll
        for (int ai = 0; ai < 2; ++ai)
#pragma unroll
            for (int m = 0; m < 4; ++m) {
                const size_t off = (size_t)(row0 + ai * 128 + m * 16) * 256 + col0;
#pragma unroll
                for (int bj = 0; bj < 2; ++bj) { const f32x4 a = acc[ai][bj][m][0], b = acc[ai][bj][m][1];
                    *(u32x4*)(Z + off + bj * 128) = (u32x4){pk2(a[0], a[1]), pk2(a[2], a[3]), pk2(b[0], b[1]), pk2(b[2], b[3])}; }
            }
    }
};
struct CmpOrder {
    int G, c;
    DI bool next(int i, pg8::Unit& u) const { const int L = i * G + c; if (L >= 2 * (XROWS / 256)) return false; u.pm = L; u.pn = L / (XROWS / 256); u.kb = 0; return true; }
    DI void a_ready(const pg8::Unit&) const {}
    DI void done(const pg8::Unit&) const {}
};

constexpr int NSPLIT = 4;
struct SplitOrder {
    int G, c, kslice_bytes;
    DI bool next(int i, pg8::Unit& u) const { const int L = i * G + c; if (L >= 32 * NSPLIT) return false; const int t = L / NSPLIT, ks = L % NSPLIT; u.pm = MP / 256 + (t >> 3); u.pn = t & 7; u.kb = ks * kslice_bytes; return true; }
    DI void a_ready(const pg8::Unit&) const {}
    DI void done(const pg8::Unit&) const {}
};
struct EpiSlab {
    static constexpr bool PERM = false, AFTER_DRAIN = false;
    float* slab; int kslice_bytes;
    DI void operator()(const f32x4 (&acc)[2][2][4][2], const pg8::Unit& u, int wr, int wc, int fr, int fq) const {
        const int row0 = (u.pm - MP / 256) * 256 + wr * 64 + fr, col0 = u.pn * 256 + wc * 32 + 4 * fq;
        float* dst = slab + (size_t)(u.kb / kslice_bytes) * MS * DM;
#pragma unroll
        for (int ai = 0; ai < 2; ++ai)
#pragma unroll
            for (int m = 0; m < 4; ++m) {
                const size_t off = (size_t)(row0 + ai * 128 + m * 16) * DM + col0;
#pragma unroll
                for (int bj = 0; bj < 2; ++bj)
#pragma unroll
                    for (int n = 0; n < 2; ++n) *(f32x4*)(dst + off + bj * 128 + n * 16) = acc[ai][bj][m][n];
            }
    }
};

struct EpiInProj {
    static constexpr bool PERM = false, AFTER_DRAIN = false;
    bf16* glain; bf16* nq; float* out; float* winrows; bf16* xblk; bf16* kb16; bf16* vt16;
    DI void operator()(const f32x4 (&acc)[2][2][4][2], const pg8::Unit& u, int wr, int wc, int fr, int fq) const {
        const int row0 = u.pm * 256 + wr * 64 + fr, pn = u.pn;
        if (pn < 12) {
            const float sc = pn < 2 ? 0.08838834764831845f : 1.f;
            const int col0 = pn * 256 + wc * 32 + 4 * fq;
#pragma unroll
            for (int ai = 0; ai < 2; ++ai)
#pragma unroll
                for (int m = 0; m < 4; ++m) {
                    const size_t off = (size_t)(row0 + ai * 128 + m * 16) * GLAW + col0;
#pragma unroll
                    for (int bj = 0; bj < 2; ++bj)
#pragma unroll
                        for (int n = 0; n < 2; ++n) { const f32x4 a = acc[ai][bj][m][n] * sc; *(u32x2*)(glain + off + bj * 128 + n * 16) = (u32x2){pk2(a[0], a[1]), pk2(a[2], a[3])}; }
                }
            return;
        }
        const int dlo = 16 * (wc & 1) + 4 * fq;
        float frev[4];
#pragma unroll
        for (int i = 0; i < 4; ++i) frev[i] = fexp2(-(float)(dlo + i) * (13.287712379549449f / 32.f)) * 0.15915494309189535f;
        const int which = pn - 16;
        const bool dorope = (pn < 16) || ((which & 1) == 0);
#pragma unroll
        for (int ai = 0; ai < 2; ++ai)
#pragma unroll
            for (int m = 0; m < 4; ++m) {
                const int row = row0 + ai * 128 + m * 16;
                const bool samp = row >= MP;
                const int srow = row - MP;
                const int pos = samp ? (TT + (srow & 7)) : (row & (TT - 1));
                float cs[4], sn[4];
#pragma unroll
                for (int i = 0; i < 4; ++i) { float rev = (float)pos * frev[i]; rev = rev - floorf(rev); cs[i] = __builtin_amdgcn_cosf(rev); sn[i] = __builtin_amdgcn_sinf(rev); }
#pragma unroll
                for (int bj = 0; bj < 2; ++bj) {
                    f32x4 x1 = acc[ai][bj][m][0], x2 = acc[ai][bj][m][1], o1, o2;
                    if (dorope) {
#pragma unroll
                        for (int i = 0; i < 4; ++i) { o1[i] = x1[i] * cs[i] - x2[i] * sn[i]; o2[i] = x2[i] * cs[i] + x1[i] * sn[i]; }
                    } else { o1 = x1; o2 = x2; }
                    const int hh = 2 * bj + (wc >> 1);
                    if (pn < 16) {
                        const int head = (pn - 12) * 4 + hh;
                        bf16* q = nq + (size_t)row * 1024 + head * 64 + dlo;
                        u32x2 w1, w2; w1.x = pk2(o1[0] * 0.125f, o1[1] * 0.125f); w1.y = pk2(o1[2] * 0.125f, o1[3] * 0.125f); w2.x = pk2(o2[0] * 0.125f, o2[1] * 0.125f); w2.y = pk2(o2[2] * 0.125f, o2[3] * 0.125f);
                        *(u32x2*)q = w1; *(u32x2*)(q + 32) = w2;
                    } else {
                        const int br = which >> 1, kvsel = which & 1;
                        const int inrow = kvsel * 256 + hh * 64 + dlo;
                        float* dst;
                        if (br == 0) dst = out + (samp ? O_CMPS + (size_t)srow * 512 : O_CMPP + (size_t)row * 512);
                        else if (br == 1) dst = out + (samp ? O_SLCS + (size_t)srow * 512 : O_SLCP + (size_t)row * 512);
                        else dst = samp ? out + O_WINS + ((size_t)(srow >> 3) * 512 + 504 + (srow & 7)) * 512 : winrows + (size_t)row * 512;
                        *(f32x4*)(dst + inrow) = o1; *(f32x4*)(dst + inrow + 32) = o2;
                        if (br == 2 && !samp && (row & (TT - 1)) >= TT - 512) {
                            float* d2 = out + O_WINP + ((size_t)(row >> 11) * 512 + (row & (TT - 1)) - (TT - 512)) * 512 + inrow;
                            *(f32x4*)d2 = o1; *(f32x4*)(d2 + 32) = o2;
                        }
                        if (br != 0 && !samp) {
                            const int b = row >> 11, t = row & (TT - 1);
                            bf16* kp = (kvsel == 0 ? kb16 : vt16) + (((size_t)(br - 1) * NB * 4 + b * 4 + hh) * TT + t) * 64 + dlo;
                            u32x2 w1, w2; w1.x = pk2(o1[0], o1[1]); w1.y = pk2(o1[2], o1[3]); w2.x = pk2(o2[0], o2[1]); w2.y = pk2(o2[2], o2[3]);
                            *(u32x2*)kp = w1; *(u32x2*)(kp + 32) = w2;
                        }
                        if (br == 0 && !samp) {
                            const int b = row >> 11, t = row & (TT - 1);
                            bf16* xb = xblk + ((size_t)kvsel * XROWS + (size_t)((NDB + b) * 4 + hh) * 128 + (t >> 4)) * 1024 + (t & 15) * 64 + dlo;
                            u32x2 w1, w2; w1.x = pk2(o1[0], o1[1]); w1.y = pk2(o1[2], o1[3]); w2.x = pk2(o2[0], o2[1]); w2.y = pk2(o2[2], o2[3]);
                            *(u32x2*)xb = w1; *(u32x2*)(xb + 32) = w2;
                        }
                    }
                }
            }
    }
};
#define XB_TMO      128
#define XB_XCNT(j)  (256  + 64 * (j))
#define XB_XSUB(j)  (1280 + 64 * (j))
#define XB_XGEN(j)  (2304 + 64 * (j))
#define XB_TOP      3328
#define XB_TOPGEN   3392
#define XCD_BAR_WORDS 3456
#define XB_SPIN_CAP (1u << 18)

__device__ __forceinline__ unsigned xb_ld(unsigned* p)              { return __hip_atomic_load(p, __ATOMIC_RELAXED, __HIP_MEMORY_SCOPE_AGENT); }
__device__ __forceinline__ unsigned xb_add(unsigned* p, unsigned v) { return __hip_atomic_fetch_add(p, v, __ATOMIC_RELAXED, __HIP_MEMORY_SCOPE_AGENT); }
__device__ __forceinline__ unsigned xb_xcc_id() { return (unsigned)__builtin_amdgcn_s_getreg((3 << 11) | 20) & 0xFu; }
#define XB_SPIN(cond, bar) do { unsigned _sp = 0; while (cond) { __builtin_amdgcn_s_sleep(1); \
    if ((++_sp & 255u) == 0u) { if (xb_ld(&(bar)[XB_TMO])) break; if (_sp > XB_SPIN_CAP) { atomicAdd(&(bar)[XB_TMO], 1u); break; } } } } while (0)

struct XcdBarrier {
    unsigned* bar; unsigned x;
    volatile LAS unsigned* st;
};

__device__ __forceinline__ XcdBarrier xcd_barrier_post(unsigned* bar, volatile LAS unsigned* st) {
    XcdBarrier b; b.bar = bar; b.x = xb_xcc_id(); b.st = st;
    if (threadIdx.x == 0) (void)xb_add(&bar[XB_XCNT(b.x)], 1u);
    return b;
}
__device__ __forceinline__ void xcd_barrier_complete(unsigned* bar, unsigned x, unsigned& nloc, unsigned& nx) {
    const unsigned G = gridDim.x * gridDim.y * gridDim.z;
    unsigned sum, cnt, mine, sp = 0u;
    for (;;) {
        sum = 0u; cnt = 0u; mine = 0u;
#pragma unroll
        for (unsigned j = 0; j < 16; ++j) { const unsigned c = xb_ld(&bar[XB_XCNT(j)]); sum += c; cnt += (c > 0u) ? 1u : 0u; mine = (j == x) ? c : mine; }
        if (sum == G) break;
        __builtin_amdgcn_s_sleep(1);
        if ((++sp & 255u) == 0u) { if (xb_ld(&bar[XB_TMO])) break; if (sp > XB_SPIN_CAP) { atomicAdd(&bar[XB_TMO], 1u); break; } }
    }
    nloc = mine > 0u ? mine : 1u; nx = cnt > 0u ? cnt : 1u;
}

__device__ __forceinline__ void xcd_barrier(const XcdBarrier& b) {
    asm volatile("s_waitcnt vmcnt(0)" ::: "memory");
    __syncthreads();
    if (threadIdx.x == 0) {
        unsigned* bar = b.bar;
        __builtin_amdgcn_s_waitcnt(0);
        unsigned nloc = b.st[0], nx = b.st[1];
        if (nloc == 0u) { xcd_barrier_complete(bar, b.x, nloc, nx); b.st[0] = nloc; b.st[1] = nx; }
        const unsigned old = xb_add(&bar[XB_XSUB(b.x)], 1u);
        const unsigned gen = old / nloc;
        if (old + 1u == (gen + 1u) * nloc) {
            __builtin_amdgcn_fence(__ATOMIC_RELEASE, "agent");
            asm volatile("s_waitcnt vmcnt(0)" ::: "memory");
            const unsigned og = xb_add(&bar[XB_TOP], 1u);
            const unsigned tg = og / nx;
            if (og + 1u == (tg + 1u) * nx) xb_add(&bar[XB_TOPGEN], 1u);
            else XB_SPIN(xb_ld(&bar[XB_TOPGEN]) == tg, bar);
            __builtin_amdgcn_fence(__ATOMIC_ACQUIRE, "agent");
            xb_add(&bar[XB_XGEN(b.x)], 1u);
            asm volatile("s_waitcnt vmcnt(0)" ::: "memory");
        } else {
            XB_SPIN(xb_ld(&bar[XB_XGEN(b.x)]) == gen, bar);
            __builtin_amdgcn_fence(__ATOMIC_ACQUIRE, "agent");
            asm volatile("s_waitcnt vmcnt(0)" ::: "memory");
        }
    }
    __syncthreads();
}

struct Frame {
    LAS unsigned char* lds;
    volatile LAS unsigned* MISC;
    gu32* ctl;
    int tid, lane, wave, vcu, G;
    const float *x_p, *x_s, *c_cmp, *c_slc, *c_win, *st_gla; const int* ptab;
    const float *w1a, *w1b, *w_in, *w_g2, *b_g2, *gnorm, *cpos, *cw1, *cw2, *w_out, *w2a, *w2b, *ln_g, *ln_b;
    float* out;
    bf16 *W1A, *W1B, *WIN, *WOUT, *W2A, *W2B, *CW1, *XB, *HB, *NQ, *MIX, *XBLK, *GQ, *GKT, *GA, *GVT, *KB16, *VT16, *KC16, *VCT16, *G16;
    float *CBIAS, *ZF, *EXTRA, *WINROWS, *ORAW, *ZC, *KCMP, *GD, *SLAB;
};

constexpr int W2A_S1 = 4500, W2A_S2 = 9000, WIN_DB1 = 20, WIN_DB2 = 84;
struct MapIdent { DI int operator()(int n) const { return n; } };
struct MapOff { int off; DI int operator()(int n) const { return off + n; } };
struct MapFfnIn { DI int operator()(int n) const { const int up = n >= DFF, c = up ? n - DFF : n; return (c >> 7) * 256 + up * 128 + (c & 127); } };
struct MapInProj {
    DI int operator()(int n) const {
        if (n < 2048) return n;
        if (n < 2064) return NIN + (n - 2048);
        if (n < 3088) return 2048 + (n - 2064);
        if (n < 5648) { const int c = n - 3088, d = c & 63, q = d >> 4; const int p = q == 1 ? d + 16 : (q == 2 ? d - 16 : d); return 3072 + (c - d) + p; }
        return n;
    }
};
template <class RowMap>
DI void transpose_item(const float* W, int ldw, int k0, int n0, bf16* WT, int ldt, int dcol0, const RowMap& rm, LAS float* scr, int lane) {
    f32x4 v[8];
#pragma unroll
    for (int i = 0; i < 8; ++i) v[i] = *(const f32x4*)(W + (size_t)(k0 + 8 * i + (lane >> 3)) * ldw + n0 + 4 * (lane & 7));
#pragma unroll
    for (int i = 0; i < 8; ++i) { LAS float* d = scr + (8 * i + (lane >> 3)) * 33 + 4 * (lane & 7); d[0] = v[i][0]; d[1] = v[i][1]; d[2] = v[i][2]; d[3] = v[i][3]; }
    LDS_WAIT(); asm volatile("" ::: "memory");
    const int c = lane & 7;
#pragma unroll
    for (int j = 0; j < 4; ++j) { const int n = (lane >> 3) + 8 * j; const LAS float* s = scr + (8 * c) * 33 + n;
        u32x4 o; o.x = pk2(s[0 * 33], s[1 * 33]); o.y = pk2(s[2 * 33], s[3 * 33]); o.z = pk2(s[4 * 33], s[5 * 33]); o.w = pk2(s[6 * 33], s[7 * 33]);
        *(u32x4*)(WT + (size_t)rm(n0 + n) * ldt + dcol0 + 8 * c) = o; }
    LDS_WAIT(); asm volatile("" ::: "memory");
}
template <class RowMap>
DI void transpose_matrix(const float* W, int K, int N, bf16* WT, const RowMap& rm, LAS float* scr, int gw, int NGW, int lane, int it0 = 0, int it1 = 0x7fffffff) {
    const int nblk = N / 32, nitems = (K / 64) * nblk < it1 ? (K / 64) * nblk : it1;
    for (int it = it0 + gw; it < nitems; it += NGW) { const int kb = it / nblk, nb = it % nblk; transpose_item(W, N, 64 * kb, 32 * nb, WT, K, 64 * kb, rm, scr, lane); }
}

DI void xblk_part(Frame& F, int rank, int nranks) {
    const int gw = rank * NWAVES + F.wave, NGW = nranks * NWAVES, lane = F.lane;
    for (int it0 = gw * 4; it0 < NDB * 2048; it0 += NGW * 4) {
        f32x4 v[4][2];
#pragma unroll
        for (int q = 0; q < 4; ++q) { const int it = it0 + q, s = it >> 11, row = it & 2047; const int page = F.ptab[s * 16 + (row >> 7)];
            const float* src = F.c_cmp + ((size_t)page * 128 + (row & 127)) * 512;
            v[q][0] = __builtin_nontemporal_load((const f32x4*)(src + 4 * lane)); v[q][1] = __builtin_nontemporal_load((const f32x4*)(src + 4 * (lane + 64))); }
#pragma unroll
        for (int q = 0; q < 4; ++q) { const int it = it0 + q, s = it >> 11, row = it & 2047;
#pragma unroll
            for (int j = 0; j < 2; ++j) { const int e = lane + 64 * j, kvsel = e >> 6, h = (e >> 4) & 3, d4 = (e & 15) * 4;
                u32x2 w; w.x = pk2(v[q][j][0], v[q][j][1]); w.y = pk2(v[q][j][2], v[q][j][3]);
                *(u32x2*)(F.XBLK + ((size_t)kvsel * XROWS + (size_t)(s * 4 + h) * 128 + (row >> 4)) * 1024 + (row & 15) * 64 + d4) = w; } }
    }
}
DI void p0_prologue(Frame& F) {
    LAS float* scr = (LAS float*)(F.lds + F.wave * 16384);
    const int gw = F.vcu * NWAVES + F.wave, NGW = F.G * NWAVES, lane = F.lane;
    transpose_matrix(F.w1a, DM, 2 * DFF, F.W1A, MapFfnIn{}, scr, gw, NGW, lane);
    for (int it = gw; it < 2 * 32 * 4; it += NGW) { const int kv = it >> 7, kb = (it >> 2) & 31, nb = it & 3;
        transpose_item(F.cw1 + (size_t)kv * 2048 * 128, 128, 64 * kb, 32 * nb, F.CW1 + (size_t)kv * 256 * 1024, 1024, (64 * kb) & 1023, MapOff{(kb >> 4) * 128}, scr, lane); }
    for (int it = gw; it < 256; it += NGW) { const int kv = it >> 7, n = it & 127; float s = 0.f;
        for (int k = lane; k < 2048; k += 64) s += F.cpos[kv * 2048 + k] * F.cw1[((size_t)kv * 2048 + k) * 128 + n];
        s = wave_sum(s); if (lane == 0) F.CBIAS[it] = s; }
    for (int m0 = 2 * gw; m0 < MTOT; m0 += 2 * NGW) {
        f32x4 v[2][8];
#pragma unroll
        for (int q = 0; q < 2; ++q) { const int m = m0 + q; const float* xr = m < MP ? F.x_p + (size_t)m * DM : F.x_s + (size_t)(m - MP) * DM;
#pragma unroll
            for (int j = 0; j < 8; ++j) v[q][j] = __builtin_nontemporal_load((const f32x4*)(xr + 4 * (lane + 64 * j))); }
#pragma unroll
        for (int q = 0; q < 2; ++q) { bf16* o = F.XB + (size_t)(m0 + q) * DM;
#pragma unroll
            for (int j = 0; j < 8; ++j) { u32x2 w; w.x = pk2(v[q][j][0], v[q][j][1]); w.y = pk2(v[q][j][2], v[q][j][3]); *(u32x2*)(o + 4 * (lane + 64 * j)) = w; } }
    }

}
DI void wincopy_part(Frame& F, int rank, int nranks, int db0, int db1) {
    const size_t per = (size_t)504 * 128, tot = (size_t)(db1 - db0) * per;
    const size_t step = (size_t)nranks * 512;
    for (size_t i0 = (size_t)rank * 512 + F.tid; i0 < tot; i0 += 8 * step) {
        f32x4 v[8];
#pragma unroll
        for (int u = 0; u < 8; ++u) { const size_t i = i0 + u * step; if (i < tot) { const size_t db = db0 + i / per, r = i % per; v[u] = __builtin_nontemporal_load((const f32x4*)F.c_win + db * (512 * 128) + 8 * 128 + r); } }
#pragma unroll
        for (int u = 0; u < 8; ++u) { const size_t i = i0 + u * step; if (i < tot) { const size_t db = db0 + i / per, r = i % per; __builtin_nontemporal_store(v[u], (f32x4*)(F.out + O_WINS) + db * (512 * 128) + r); } }
    }
}

DI void late_work(Frame& F, int part, int rank, int nranks) {
    LAS float* scr = (LAS float*)(F.lds + F.wave * 16384);
    const int gw = rank * NWAVES + F.wave, NGW = nranks * NWAVES, lane = F.lane;
    __syncthreads();
    if (part == 1) { transpose_matrix(F.w1b, DFF, DM, F.W1B, MapIdent{}, scr, gw, NGW, lane); transpose_matrix(F.w_out, DM, DM, F.WOUT, MapIdent{}, scr, gw, NGW, lane); }
    else if (part == 2) { transpose_matrix(F.w_in, DM, NIN + NEXTRA, F.WIN, MapInProj{}, scr, gw, NGW, lane); transpose_matrix(F.w2a, DM, 2 * DFF, F.W2A, MapFfnIn{}, scr, gw, NGW, lane, 0, W2A_S1); }
    else if (part == 4) transpose_matrix(F.w2a, DM, 2 * DFF, F.W2A, MapFfnIn{}, scr, gw, NGW, lane, W2A_S1, W2A_S2);
    else if (part == 8) transpose_matrix(F.w2a, DM, 2 * DFF, F.W2A, MapFfnIn{}, scr, gw, NGW, lane, W2A_S2);
    else if (part == 10) { transpose_matrix(F.w2b, DFF, DM, F.W2B, MapIdent{}, scr, gw, NGW, lane); wincopy_part(F, rank, nranks, 0, WIN_DB1); }
    else if (part == 11) wincopy_part(F, rank, nranks, WIN_DB1, WIN_DB2);
    else if (part == 5) wincopy_part(F, rank, nranks, WIN_DB2, NDB);
    __syncthreads();
}
DI void late_tail(Frame& F, int part, int bx, int busy) {
    if (busy % F.G == 0) late_work(F, part, bx, F.G); else if (bx >= busy % F.G) late_work(F, part, bx - busy % F.G, F.G - busy % F.G);
}
DI void ln_finish(f32x4 (&v)[8], int m, int lane, float* outf, bf16* outb, const LAS float* g, const LAS float* b) {
    float s = 0.f;
#pragma unroll
    for (int j = 0; j < 8; ++j) s += (v[j][0] + v[j][1]) + (v[j][2] + v[j][3]);
    const float mean = wave_sum(s) * (1.f / DM); float s2 = 0.f;
#pragma unroll
    for (int j = 0; j < 8; ++j) { v[j] = v[j] - mean; s2 += (v[j][0] * v[j][0] + v[j][1] * v[j][1]) + (v[j][2] * v[j][2] + v[j][3] * v[j][3]); }
    const float rstd = 1.f / sqrtf(wave_sum(s2) * (1.f / DM) + LN_EPS);
#pragma unroll
    for (int j = 0; j < 4; ++j) { const int c = 8 * (lane + 64 * j);
        const f32x4 y0 = v[2 * j] * rstd * *(const LAS f32x4*)(g + c) + *(const LAS f32x4*)(b + c), y1 = v[2 * j + 1] * rstd * *(const LAS f32x4*)(g + c + 4) + *(const LAS f32x4*)(b + c + 4);
        if (outf) { __builtin_nontemporal_store(y0, (f32x4*)(outf + (size_t)m * DM + c)); __builtin_nontemporal_store(y1, (f32x4*)(outf + (size_t)m * DM + c + 4)); }
        if (outb) *(u32x4*)(outb + (size_t)m * DM + c) = (u32x4){pk2(y0[0], y0[1]), pk2(y0[2], y0[3]), pk2(y1[0], y1[1]), pk2(y1[2], y1[3])}; }
}
DI void ln_prompt_row(const bf16* zb, int m, int mpf, u32x4 (&nq)[4], int lane, float* outf, bf16* outb, const LAS float* g, const LAS float* b) {
    f32x4 v[8];
#pragma unroll
    for (int j = 0; j < 4; ++j) { v[2 * j] = bf4_lo(nq[j]); v[2 * j + 1] = bf4_hi(nq[j]); }
    if (mpf < MP) {
#pragma unroll
        for (int j = 0; j < 4; ++j) nq[j] = *(const u32x4*)(zb + (size_t)mpf * DM + 8 * (lane + 64 * j));
    }
    ln_finish(v, m, lane, outf, outb, g, b);
}
DI void ln_phase(Frame& F, const bf16* zb, float* outf, bf16* outb, const float* gg, const float* gb, const float* res_s, const bf16* res16, float sc) {
    const int gw = F.vcu * NWAVES + F.wave, NGW = F.G * NWAVES, lane = F.lane;
    LAS float* g = (LAS float*)F.lds; LAS float* b = g + DM;
    const f32x4 g4 = *(const f32x4*)(gg + 4 * F.tid), b4 = *(const f32x4*)(gb + 4 * F.tid);
    u32x4 qa[4], qb[4], qc[4];
    if (gw < MP) {
#pragma unroll
        for (int j = 0; j < 4; ++j) qa[j] = *(const u32x4*)(zb + (size_t)gw * DM + 8 * (lane + 64 * j));
    }
    if (gw + NGW < MP) {
#pragma unroll
        for (int j = 0; j < 4; ++j) qb[j] = *(const u32x4*)(zb + (size_t)(gw + NGW) * DM + 8 * (lane + 64 * j));
    }
    if (gw + 2 * NGW < MP) {
#pragma unroll
        for (int j = 0; j < 4; ++j) qc[j] = *(const u32x4*)(zb + (size_t)(gw + 2 * NGW) * DM + 8 * (lane + 64 * j));
    }
    *(LAS f32x4*)(g + 4 * F.tid) = g4; *(LAS f32x4*)(b + 4 * F.tid) = b4;
    __syncthreads();
    for (int ms = F.vcu + F.G * F.wave; ms < MS; ms += NGW) { const size_t o = (size_t)ms * DM; f32x4 v[8];
#pragma unroll
        for (int j = 0; j < 4; ++j)
#pragma unroll
            for (int hh = 0; hh < 2; ++hh) { const size_t e = o + 8 * (lane + 64 * j) + 4 * hh; f32x4 a = *(const f32x4*)(F.SLAB + e);
#pragma unroll
                for (int q = 1; q < NSPLIT; ++q) a = a + *(const f32x4*)(F.SLAB + (size_t)q * MS * DM + e);
                f32x4 rv;
                if (res_s) rv = *(const f32x4*)(res_s + e);
                else { const u32x2 q2 = *(const u32x2*)(res16 + e); rv = (f32x4){__builtin_bit_cast(float, q2.x << 16), __builtin_bit_cast(float, q2.x & 0xffff0000u), __builtin_bit_cast(float, q2.y << 16), __builtin_bit_cast(float, q2.y & 0xffff0000u)}; }
                v[2 * j + hh] = rv * ALPHA + a * sc; }
        ln_finish(v, MP + ms, lane, outf, outb, g, b);
    }
    for (int m = gw; m < MP; m += 3 * NGW) {
        ln_prompt_row(zb, m, m + 3 * NGW, qa, lane, outf, outb, g, b);
        if (m + NGW < MP) ln_prompt_row(zb, m + NGW, m + 4 * NGW, qb, lane, outf, outb, g, b);
        if (m + 2 * NGW < MP) ln_prompt_row(zb, m + 2 * NGW, m + 5 * NGW, qc, lane, outf, outb, g, b);
    }
}

struct XOps { bf16x8 a[4]; bf16x8 b[4][4]; };
DI void xops_load(XOps& o, const bf16* ap, const bf16* bp, int k0) {
#pragma unroll
    for (int ks = 0; ks < 4; ++ks) { o.a[ks] = *(const bf16x8*)(ap + k0 + 32 * ks);
#pragma unroll
        for (int n = 0; n < 4; ++n) o.b[ks][n] = *(const bf16x8*)(bp + (size_t)n * 16 * DM + k0 + 32 * ks); }
}
DI void xops_mma(const XOps& o, f32x4 (&acc)[4]) {
#pragma unroll
    for (int ks = 0; ks < 4; ++ks)
#pragma unroll
        for (int n = 0; n < 4; ++n) acc[n] = __builtin_amdgcn_mfma_f32_16x16x32_bf16(o.a[ks], o.b[ks][n], acc[n], 0, 0, 0);
}
DI void extra_phase(Frame& F, int rank, int nranks) {
    const int lane = F.lane, w = F.wave, r = lane & 15, kq = lane >> 4, tile = w >> 2, q4 = w & 3;
    LAS float* PART = (LAS float*)F.lds;
    const bf16* Bt = F.WIN + (size_t)NIN * DM;
    for (int it = rank; it < MTOT / 32; it += nranks) {
        const bf16* ap = F.XB + (size_t)(it * 32 + tile * 16 + r) * DM + 512 * q4 + 8 * kq;
        const bf16* bp = Bt + (size_t)r * DM + 512 * q4 + 8 * kq;
        f32x4 acc[4];
#pragma unroll
        for (int n = 0; n < 4; ++n) acc[n] = (f32x4){0.f, 0.f, 0.f, 0.f};
        XOps R0, R1;
        xops_load(R0, ap, bp, 0); xops_load(R1, ap, bp, 128);
        xops_mma(R0, acc); xops_load(R0, ap, bp, 256);
        xops_mma(R1, acc); xops_load(R1, ap, bp, 384);
        xops_mma(R0, acc); xops_mma(R1, acc);
#pragma unroll
        for (int n = 0; n < 4; ++n)
#pragma unroll
            for (int i = 0; i < 4; ++i) PART[(w * 16 + 4 * kq + i) * 64 + n * 16 + r] = acc[n][i];
        __syncthreads();
        { const int t2 = F.tid >> 8, e = F.tid & 255, row = e >> 4, c4 = (e & 15) * 4;
          f32x4 s = *(const LAS f32x4*)(PART + ((t2 * 4 + 0) * 16 + row) * 64 + c4);
#pragma unroll
          for (int q = 1; q < 4; ++q) s = s + *(const LAS f32x4*)(PART + ((t2 * 4 + q) * 16 + row) * 64 + c4);
          *(f32x4*)(F.EXTRA + (size_t)(it * 32 + t2 * 16 + row) * 64 + c4) = s; }
        __syncthreads();
    }
}

DI f32x4 ldbf4(const bf16* p) { const u32x2 q = *(const u32x2*)p; return (f32x4){__builtin_bit_cast(float, q.x << 16), __builtin_bit_cast(float, q.x & 0xffff0000u), __builtin_bit_cast(float, q.y << 16), __builtin_bit_cast(float, q.y & 0xffff0000u)}; }
DI float ldbf(const bf16* p) { return __builtin_bit_cast(float, (unsigned)(*p) << 16); }
DI float log_sigmoid_(float x) { return fminf(x, 0.f) - __logf(1.f + __expf(-fabsf(x))); }
#define MFMA4(a, b, c) __builtin_amdgcn_mfma_f32_16x16x4f32((a), (b), (c), 0, 0, 0)

constexpr int GLP = 132, G_QH = 0, G_KH = G_QH + 64 * GLP, G_END = G_KH + 64 * GLP;
static_assert(G_END * 4 <= RING_BYTES && 64 * 260 <= G_END, "GLA LDS map");
constexpr int G_X0 = (MISC_OFF + 256) / 4, G_GA = G_X0, G_PART = G_GA + 64 * 16, G_XEND = G_PART + 512;
static_assert(G_XEND * 4 <= LDS_BYTES, "GLA LDS map 2");
#define MFMA16(a, b, c) __builtin_amdgcn_mfma_f32_16x16x32_bf16((a), (b), (c), 0, 0, 0)
DI bf16x8 ld8_f32_as_bf16(const LAS float* p) { const f32x4 a = *(const LAS f32x4*)p, b = *(const LAS f32x4*)(p + 4); u32x4 w; w.x = pk2(a[0], a[1]); w.y = pk2(a[2], a[3]); w.z = pk2(b[0], b[1]); w.w = pk2(b[2], b[3]); return __builtin_bit_cast(bf16x8, w); }

struct PreRegs { u32x2 q[4], k[4], v[8]; f32x4 ga; };
DI void pre_load_qk(Frame& F, PreRegs& R, int item, int tid) {
    const int c = item & 31, h = (item >> 5) & 3, b = item >> 7; const size_t row0 = (size_t)b * TT + 64 * c;
#pragma unroll
    for (int i = 0; i < 4; ++i) { const int idx = tid + 512 * i, row = idx >> 5, c4 = idx & 31; const bf16* g = F.G16 + (row0 + row) * GLAW + h * 128 + 4 * c4;
        R.q[i] = *(const u32x2*)g; R.k[i] = *(const u32x2*)(g + 512); }
    R.ga = (f32x4){0.f, 0.f, 0.f, 0.f};
    if (tid < 256) { const int row = tid >> 2, c4 = tid & 3; R.ga = *(const f32x4*)(F.EXTRA + (row0 + row) * 64 + 4 * c4); }
}
DI void pre_load_v(Frame& F, PreRegs& R, int item, int tid) {
    const int c = item & 31, h = (item >> 5) & 3, b = item >> 7; const size_t row0 = (size_t)b * TT + 64 * c;
#pragma unroll
    for (int i = 0; i < 8; ++i) { const int idx = tid + 512 * i, row = idx >> 6, c4 = idx & 63; R.v[i] = *(const u32x2*)(F.G16 + (row0 + row) * GLAW + 1024 + h * 256 + 4 * c4); }
}
DI f32x4 bf2x2(u32x2 q) { return (f32x4){__builtin_bit_cast(float, q.x << 16), __builtin_bit_cast(float, q.x & 0xffff0000u), __builtin_bit_cast(float, q.y << 16), __builtin_bit_cast(float, q.y & 0xffff0000u)}; }
DI void gla_pre_item(Frame& F, int item, PreRegs& R, int nxt) {
    LAS float* L = (LAS float*)F.lds;
    LAS float *QH = L + G_QH, *KH = L + G_KH, *VS = L, *GA = L + G_GA, *PART = L + G_PART;
    const int tid = F.tid, lane = F.lane, w = F.wave, r16 = lane & 15, kq = lane >> 4;
    const int h = (item >> 5) & 3;
    const int kk = tid & 127, tq = tid >> 7;
    __syncthreads();
#pragma unroll
    for (int i = 0; i < 4; ++i) { const int idx = tid + 512 * i, row = idx >> 5, c4 = idx & 31; *(LAS f32x4*)(QH + row * GLP + 4 * c4) = bf2x2(R.q[i]); *(LAS f32x4*)(KH + row * GLP + 4 * c4) = bf2x2(R.k[i]); }
    if (tid < 256) { const int row = tid >> 2, c4 = tid & 3; *(LAS f32x4*)(GA + row * 16 + 4 * c4) = R.ga; }
    float w2r[16];
#pragma unroll
    for (int r = 0; r < 16; ++r) w2r[r] = F.w_g2[r * 512 + h * 128 + kk];
    const float b2 = F.b_g2[h * 128 + kk];
    __syncthreads();
    float cum[16]; float run = 0.f;
#pragma unroll
    for (int i = 0; i < 16; ++i) { const int t = 16 * tq + i; float x = b2;
#pragma unroll
        for (int r = 0; r < 16; ++r) x += GA[t * 16 + r] * w2r[r];
        run += log_sigmoid_(x) * (1.f / 16.f); cum[i] = run; }
    PART[tq * 128 + kk] = run;
    __syncthreads();
    float off = 0.f;
#pragma unroll
    for (int j = 0; j < 3; ++j) off += (j < tq) ? PART[j * 128 + kk] : 0.f;
#pragma unroll
    for (int i = 0; i < 16; ++i) { const int t = 16 * tq + i; const float e = __expf(cum[i] + off); QH[t * GLP + kk] *= e; KH[t * GLP + kk] *= frcp(e); }
    if (tq == 3) F.GD[(size_t)item * 128 + kk] = __expf(cum[15] + off);
    __syncthreads();
    if (nxt >= 0) pre_load_qk(F, R, nxt, tid);
    { const int row = tid >> 3, c0 = (tid & 7) * 16; bf16* dst = F.GQ + ((size_t)item * 64 + row) * 128 + c0;
      *(bf16x8*)dst = ld8_f32_as_bf16(QH + row * GLP + c0); *(bf16x8*)(dst + 8) = ld8_f32_as_bf16(QH + row * GLP + c0 + 8); }
    { const int k = tid >> 2, j0 = (tid & 3) * 16; float v[16];
#pragma unroll
      for (int j = 0; j < 16; ++j) v[j] = KH[(j0 + j) * GLP + k];
      u32x4 a, bq; a.x = pk2(v[0], v[1]); a.y = pk2(v[2], v[3]); a.z = pk2(v[4], v[5]); a.w = pk2(v[6], v[7]); bq.x = pk2(v[8], v[9]); bq.y = pk2(v[10], v[11]); bq.z = pk2(v[12], v[13]); bq.w = pk2(v[14], v[15]);
      bf16* dst = F.GKT + ((size_t)item * 128 + k) * 64 + j0; *(u32x4*)dst = a; *(u32x4*)(dst + 8) = bq; }
#pragma unroll
    for (int q = 0; q < 2; ++q) { const int tile = 2 * w + q, ti = tile >> 2, tj = tile & 3;
        f32x4 a = {0.f, 0.f, 0.f, 0.f};
        if (tj <= ti) {
#pragma unroll
            for (int s = 0; s < 4; ++s) a = MFMA16(ld8_f32_as_bf16(KH + (16 * tj + r16) * GLP + 32 * s + 8 * kq), ld8_f32_as_bf16(QH + (16 * ti + r16) * GLP + 32 * s + 8 * kq), a);
        }
        const int ri = 16 * ti + r16, cj = 16 * tj + 4 * kq;
        *(u32x2*)(F.GA + ((size_t)item * 64 + ri) * 64 + cj) = (u32x2){pk2(cj <= ri ? a[0] : 0.f, cj + 1 <= ri ? a[1] : 0.f), pk2(cj + 2 <= ri ? a[2] : 0.f, cj + 3 <= ri ? a[3] : 0.f)};
    }
    __syncthreads();
#pragma unroll
    for (int i = 0; i < 8; ++i) { const int idx = tid + 512 * i, row = idx >> 6, c4 = idx & 63; *(LAS f32x4*)(VS + row * 260 + 4 * c4) = bf2x2(R.v[i]); }
    if (nxt >= 0) pre_load_v(F, R, nxt, tid);
    __syncthreads();
    { const int v = tid >> 1, j0 = (tid & 1) * 32; bf16* dst = F.GVT + ((size_t)item * 256 + v) * 64 + j0;
#pragma unroll
      for (int g = 0; g < 4; ++g) { float x[8];
#pragma unroll
          for (int j = 0; j < 8; ++j) x[j] = VS[(j0 + 8 * g + j) * 260 + v];
          u32x4 a; a.x = pk2(x[0], x[1]); a.y = pk2(x[2], x[3]); a.z = pk2(x[4], x[5]); a.w = pk2(x[6], x[7]); *(u32x4*)(dst + 8 * g) = a; } }
}

struct GlaOps { bf16x8 aA0, aA1, aQ0, aQ1, aQ2, aQ3, bK0, bK1; u32x4 vs; float dD; };
DI void gla_seq_load(Frame& F, GlaOps& o, int item, int vs, int w, int r16, int kq, int tid) {
    const int ti = w >> 1;
    const bf16* ga = F.GA + ((size_t)item * 64 + 16 * ti + r16) * 64 + 8 * kq; const bf16* gq = F.GQ + ((size_t)item * 64 + 16 * ti + r16) * 128 + 8 * kq;
    const bf16* gk = F.GKT + ((size_t)item * 128 + 16 * w + r16) * 64 + 8 * kq;
    o.aA0 = *(const bf16x8*)ga; o.aA1 = *(const bf16x8*)(ga + 32); o.bK0 = *(const bf16x8*)gk; o.bK1 = *(const bf16x8*)(gk + 32);
    o.aQ0 = *(const bf16x8*)gq; o.aQ1 = *(const bf16x8*)(gq + 32); o.aQ2 = *(const bf16x8*)(gq + 64); o.aQ3 = *(const bf16x8*)(gq + 96);
    o.vs = *(const u32x4*)(F.GVT + ((size_t)item * 256 + 64 * vs) * 64 + tid * 8);
    o.dD = F.GD[(size_t)item * 128 + 16 * w + r16];
}
DI void gla_seq_step(Frame& F, const GlaOps& cur, const GlaOps& nxt, f32x4 (&acc)[4], LAS bf16* ST, int b, int h, int vs, int c, int w, int r16, int kq, int tid) {
    const int ti = w >> 1, tp = w & 1;
    const LAS bf16* Sc = ST + (c & 1) * 64 * 136; LAS bf16* Sn = ST + ((c & 1) ^ 1) * 64 * 136;
    const LAS bf16* Vc = (const LAS bf16*)((LAS unsigned char*)ST + 69632) + (c & 1) * 64 * 72; LAS bf16* Vn = (LAS bf16*)((LAS unsigned char*)ST + 69632) + ((c & 1) ^ 1) * 64 * 72;
    *(LAS u32x4*)(Vn + (tid >> 3) * 72 + (tid & 7) * 8) = nxt.vs;
    f32x4 o0 = {0.f, 0.f, 0.f, 0.f}, o1 = o0;
    { const LAS bf16* vp = Vc + (32 * tp + r16) * 72 + 8 * kq;
      o0 = MFMA16(cur.aA0, *(const LAS bf16x8*)vp, o0); o0 = MFMA16(cur.aA1, *(const LAS bf16x8*)(vp + 32), o0);
      o1 = MFMA16(cur.aA0, *(const LAS bf16x8*)(vp + 16 * 72), o1); o1 = MFMA16(cur.aA1, *(const LAS bf16x8*)(vp + 16 * 72 + 32), o1); }
    { const LAS bf16* sp = Sc + (32 * tp + r16) * 136 + 8 * kq;
      o0 = MFMA16(cur.aQ0, *(const LAS bf16x8*)sp, o0); o0 = MFMA16(cur.aQ1, *(const LAS bf16x8*)(sp + 32), o0); o0 = MFMA16(cur.aQ2, *(const LAS bf16x8*)(sp + 64), o0); o0 = MFMA16(cur.aQ3, *(const LAS bf16x8*)(sp + 96), o0);
      sp += 16 * 136;
      o1 = MFMA16(cur.aQ0, *(const LAS bf16x8*)sp, o1); o1 = MFMA16(cur.aQ1, *(const LAS bf16x8*)(sp + 32), o1); o1 = MFMA16(cur.aQ2, *(const LAS bf16x8*)(sp + 64), o1); o1 = MFMA16(cur.aQ3, *(const LAS bf16x8*)(sp + 96), o1); }
    { LAS float* ob = (LAS float*)(ST + 2 * 64 * 136) + (c & 1) * 64 * 68 + (16 * ti + 4 * kq) * 68 + 32 * tp + r16;
#pragma unroll
      for (int i = 0; i < 4; ++i) { ob[i * 68] = o0[i]; ob[i * 68 + 16] = o1[i]; } }
#pragma unroll
    for (int tv = 0; tv < 4; ++tv) { const LAS bf16* vp = Vc + (16 * tv + r16) * 72 + 8 * kq;
        acc[tv] = MFMA16(*(const LAS bf16x8*)vp, cur.bK0, acc[tv]); acc[tv] = MFMA16(*(const LAS bf16x8*)(vp + 32), cur.bK1, acc[tv]); acc[tv] = acc[tv] * cur.dD; }
#pragma unroll
    for (int tv = 0; tv < 4; ++tv)
#pragma unroll
        for (int i = 0; i < 4; ++i) Sn[(16 * tv + 4 * kq + i) * 136 + 16 * w + r16] = (bf16)(pk2(acc[tv][i], 0.f) & 0xffffu);
    __syncthreads();
}
DI void gla_seq_flush(Frame& F, LAS bf16* ST, int b, int h, int vs, int c) {
    const int row = F.tid >> 3, seg = F.tid & 7;
    const LAS float* ob = (const LAS float*)(ST + 2 * 64 * 136) + (c & 1) * 64 * 68 + row * 68 + 4 * seg;
    float* op = F.ORAW + ((size_t)b * TT + 64 * c + row) * 1024 + h * 256 + 64 * vs + 4 * seg;
    *(f32x4*)op = *(const LAS f32x4*)ob; *(f32x4*)(op + 32) = *(const LAS f32x4*)(ob + 32);
}
DI void gla_seq_unit(Frame& F, int b, int h, int vs) {
    LAS bf16* ST = (LAS bf16*)F.lds;
    int tid_ = F.tid; asm volatile("" : "+v"(tid_));
    const int tid = tid_, lane = tid & 63, w = F.wave, r16 = lane & 15, kq = lane >> 4;
    __syncthreads();
    for (int i = tid; i < 2 * 64 * 136 / 2; i += 512) ((LAS unsigned*)ST)[i] = 0u;
    f32x4 acc[4];
#pragma unroll
    for (int tv = 0; tv < 4; ++tv) acc[tv] = (f32x4){0.f, 0.f, 0.f, 0.f};
    const int item0 = (b * 4 + h) * 32;
    GlaOps R0, R1, R2;
    gla_seq_load(F, R0, item0, vs, w, r16, kq, tid); gla_seq_load(F, R1, item0 + 1, vs, w, r16, kq, tid);
    *(LAS u32x4*)((LAS bf16*)((LAS unsigned char*)ST + 69632) + (tid >> 3) * 72 + (tid & 7) * 8) = R0.vs;
    __syncthreads();
#pragma unroll 1
    for (int c = 0; c < 30; c += 3) {
        gla_seq_load(F, R2, item0 + c + 2, vs, w, r16, kq, tid); if (c > 0) gla_seq_flush(F, ST, b, h, vs, c - 1); gla_seq_step(F, R0, R1, acc, ST, b, h, vs, c, w, r16, kq, tid);
        gla_seq_load(F, R0, item0 + c + 3, vs, w, r16, kq, tid); gla_seq_flush(F, ST, b, h, vs, c);     gla_seq_step(F, R1, R2, acc, ST, b, h, vs, c + 1, w, r16, kq, tid);
        gla_seq_load(F, R1, item0 + (c + 4 < 32 ? c + 4 : 31), vs, w, r16, kq, tid); gla_seq_flush(F, ST, b, h, vs, c + 1); gla_seq_step(F, R2, R0, acc, ST, b, h, vs, c + 2, w, r16, kq, tid);
    }
    gla_seq_flush(F, ST, b, h, vs, 29); gla_seq_step(F, R0, R1, acc, ST, b, h, vs, 30, w, r16, kq, tid);
    gla_seq_flush(F, ST, b, h, vs, 30); gla_seq_step(F, R1, R1, acc, ST, b, h, vs, 31, w, r16, kq, tid);
    gla_seq_flush(F, ST, b, h, vs, 31);
#pragma unroll
    for (int tv = 0; tv < 4; ++tv)
#pragma unroll
        for (int i = 0; i < 4; ++i) F.out[O_GLAP + ((size_t)(b * 4 + h) * 128 + 16 * w + r16) * 256 + 64 * vs + 16 * tv + 4 * kq + i] = acc[tv][i];
}

DI void gla_sample_unit(Frame& F, int db, int h) {
    LAS float* L = (LAS float*)F.lds;
    LAS float *QH = L, *KH = L + 1024, *VV = L + 2048, *AA = L + 4096, *DD = L + 4160, *GA = L + 4288, *OP = L + 4416;
    const int tid = F.tid, lane = F.lane, w = F.wave;
    const size_t row0 = (size_t)MP + db * 8;
    __syncthreads();
    for (int i = tid; i < 8 * 128; i += 512) { const int t = i >> 7, k = i & 127; QH[i] = ldbf(F.G16 + (row0 + t) * GLAW + h * 128 + k); KH[i] = ldbf(F.G16 + (row0 + t) * GLAW + 512 + h * 128 + k); }
    for (int i = tid; i < 8 * 256; i += 512) { const int t = i >> 8, v = i & 255; VV[i] = ldbf(F.G16 + (row0 + t) * GLAW + 1024 + h * 256 + v); }
    if (tid < 128) GA[tid] = F.EXTRA[(row0 + (tid >> 4)) * 64 + (tid & 15)];
    __syncthreads();
    if (tid < 128) { const int k = tid; float run = 0.f;
        float w2r[16];
#pragma unroll
        for (int r = 0; r < 16; ++r) w2r[r] = F.w_g2[r * 512 + h * 128 + k];
        const float b2 = F.b_g2[h * 128 + k];
#pragma unroll
        for (int t = 0; t < 8; ++t) { float x = b2;
#pragma unroll
            for (int r = 0; r < 16; ++r) x += GA[t * 16 + r] * w2r[r];
            run += log_sigmoid_(x) * (1.f / 16.f); const float e = __expf(run); QH[t * 128 + k] *= e; KH[t * 128 + k] *= frcp(e); }
        DD[k] = __expf(run); }
    __syncthreads();
    if (tid < 64) { const int i = tid >> 3, j = tid & 7; float a = 0.f;
        if (j <= i) for (int k = 0; k < 128; ++k) a += QH[i * 128 + k] * KH[j * 128 + k];
        AA[tid] = a; }
    __syncthreads();
    const int c4 = 4 * lane;
    f32x4 v[8], o[8];
#pragma unroll
    for (int t = 0; t < 8; ++t) { v[t] = *(const LAS f32x4*)(VV + t * 256 + c4); o[t] = (f32x4){0.f, 0.f, 0.f, 0.f}; }
    const float* S0 = F.st_gla + ((size_t)(db * 4 + h) * 128 + 16 * w) * 256 + c4;
    float* S1 = F.out + O_GLAS + ((size_t)(db * 4 + h) * 128 + 16 * w) * 256 + c4;
    f32x4 sv[16];
#pragma unroll
    for (int k = 0; k < 16; ++k) sv[k] = __builtin_nontemporal_load((const f32x4*)(S0 + (size_t)k * 256));
#pragma unroll
    for (int k = 0; k < 16; ++k) { const int kk = 16 * w + k; const f32x4 s = sv[k]; f32x4 acc = s;
#pragma unroll
        for (int t = 0; t < 8; ++t) { o[t] = o[t] + QH[t * 128 + kk] * s; acc = acc + KH[t * 128 + kk] * v[t]; }
        __builtin_nontemporal_store(acc * DD[kk], (f32x4*)(S1 + (size_t)k * 256)); }
#pragma unroll
    for (int t = 0; t < 8; ++t) *(LAS f32x4*)(OP + (w * 8 + t) * 256 + c4) = o[t];
    __syncthreads();
    { const int t = tid >> 6; float ov[4]; float ss = 0.f;
#pragma unroll
        for (int q = 0; q < 4; ++q) { const int cc = lane + 64 * q; float x = 0.f;
#pragma unroll
            for (int g = 0; g < 8; ++g) x += OP[(g * 8 + t) * 256 + cc];
#pragma unroll
            for (int j = 0; j < 8; ++j) x += AA[t * 8 + j] * VV[j * 256 + cc];
            ov[q] = x; ss += x * x; }
        ss = wave_sum(ss); const float rs = 1.f / sqrtf(ss * (1.f / 256.f) + LN_EPS);
#pragma unroll
        for (int q = 0; q < 4; ++q) { const int cc = lane + 64 * q; const float gr = ldbf(F.G16 + (row0 + t) * GLAW + 2048 + h * 256 + cc);
            const float y = ov[q] * rs * F.gnorm[cc] * siluf_(gr);
            F.MIX[(row0 + t) * DM + h * 256 + cc] = (bf16)(pk2(y, 0.f) & 0xffffu); }
    }
    __syncthreads();
}

DI void gla_finalize_phase(Frame& F) {
    int lane = F.lane; asm volatile("" : "+v"(lane));
    const int gw = F.vcu * NWAVES + F.wave, NGW = F.G * NWAVES;
    const f32x4 gn = *(const f32x4*)(F.gnorm + 4 * lane);
    for (int it0 = 4 * gw; it0 < MP * 4; it0 += 4 * NGW) {
        const int row = it0 >> 2;
        f32x4 o[4], gr[4];
#pragma unroll
        for (int h = 0; h < 4; ++h) { o[h] = *(const f32x4*)(F.ORAW + (size_t)row * 1024 + h * 256 + 4 * lane); gr[h] = ldbf4(F.G16 + (size_t)row * GLAW + 2048 + h * 256 + 4 * lane); }
#pragma unroll
        for (int h = 0; h < 4; ++h) {
            const float ss = wave_sum((o[h][0] * o[h][0] + o[h][1] * o[h][1]) + (o[h][2] * o[h][2] + o[h][3] * o[h][3]));
            const float rs = 1.f / sqrtf(ss * (1.f / 256.f) + LN_EPS);
            u32x2 wv; wv.x = pk2(o[h][0] * rs * gn[0] * siluf_(gr[h][0]), o[h][1] * rs * gn[1] * siluf_(gr[h][1])); wv.y = pk2(o[h][2] * rs * gn[2] * siluf_(gr[h][2]), o[h][3] * rs * gn[3] * siluf_(gr[h][3]));
            *(u32x2*)(F.MIX + (size_t)row * DM + h * 256 + 4 * lane) = wv; }
    }
}

DI float gelu_tanh_(float x) { const float u = 0.7978845608028654f * (x + 0.044715f * x * x * x); const float e = fexp2(2.f * u * LOG2E); const float th = 1.f - 2.f * frcp(e + 1.f); return 0.5f * x * (1.f + th); }
DI void zc_load(const bf16* Z, u32x4 (&za)[4], u32x4 (&zb)[4], int tid) {
    const int n8 = (tid & 15) * 8, i0 = tid >> 4;
#pragma unroll
    for (int q = 0; q < 4; ++q) { const int i = i0 + 32 * q; za[q] = *(const u32x4*)(Z + (size_t)i * 256 + n8); zb[q] = *(const u32x4*)(Z + (size_t)(i < 127 ? i + 1 : i) * 256 + 128 + n8); }
}
DI float bflo(unsigned u) { return __builtin_bit_cast(float, u << 16); }
DI float bfhi(unsigned u) { return __builtin_bit_cast(float, u & 0xffff0000u); }
DI void zcombine_phase(Frame& F, int rank, int nranks) {
    LAS bf16* W2T = (LAS bf16*)F.lds; LAS bf16* Y = (LAS bf16*)(F.lds + 34816);
    const int tid = F.tid, lane = F.lane, w = F.wave, r16 = lane & 15, kq = lane >> 4;
    const bf16* ZB = (const bf16*)F.ZC;
    __syncthreads();
    for (int e = tid; e < 2 * 128 * 64; e += 512) { const int kv = e >> 13, n = (e >> 6) & 127, d = e & 63; W2T[(kv * 64 + d) * 136 + n] = (bf16)(pk2(F.cw2[e], 0.f) & 0xffffu); }
    const int ngroups = 2 * NSEQ * 4;
    u32x4 za[4], zb[4];
    int gidx = rank;
    if (gidx < ngroups) zc_load(ZB + (size_t)gidx * 128 * 256, za, zb, tid);
    __syncthreads();
    for (; gidx < ngroups; gidx += nranks) {
        const int kv = gidx / (NSEQ * 4), sh = gidx % (NSEQ * 4);
        { const int n8 = (tid & 15) * 8, i0 = tid >> 4; const f32x4 cb0 = *(const f32x4*)(F.CBIAS + kv * 128 + n8), cb1 = *(const f32x4*)(F.CBIAS + kv * 128 + n8 + 4);
#pragma unroll
          for (int q = 0; q < 4; ++q) { const int i = i0 + 32 * q; float y[8];
              y[0] = bflo(za[q].x) + bflo(zb[q].x) + cb0[0]; y[1] = bfhi(za[q].x) + bfhi(zb[q].x) + cb0[1]; y[2] = bflo(za[q].y) + bflo(zb[q].y) + cb0[2]; y[3] = bfhi(za[q].y) + bfhi(zb[q].y) + cb0[3];
              y[4] = bflo(za[q].z) + bflo(zb[q].z) + cb1[0]; y[5] = bfhi(za[q].z) + bfhi(zb[q].z) + cb1[1]; y[6] = bflo(za[q].w) + bflo(zb[q].w) + cb1[2]; y[7] = bfhi(za[q].w) + bfhi(zb[q].w) + cb1[3];
#pragma unroll
              for (int j = 0; j < 8; ++j) y[j] = (i == 127) ? 0.f : gelu_tanh_(y[j]);
              *(LAS u32x4*)(Y + i * 136 + n8) = (u32x4){pk2(y[0], y[1]), pk2(y[2], y[3]), pk2(y[4], y[5]), pk2(y[6], y[7])}; } }
        __syncthreads();
        if (gidx + nranks < ngroups) zc_load(ZB + (size_t)(gidx + nranks) * 128 * 256, za, zb, tid);
        f32x4 acc[4];
#pragma unroll
        for (int t = 0; t < 4; ++t) acc[t] = (f32x4){0.f, 0.f, 0.f, 0.f};
#pragma unroll
        for (int s = 0; s < 4; ++s) { const bf16x8 yb = *(const LAS bf16x8*)(Y + (16 * w + r16) * 136 + 32 * s + 8 * kq);
#pragma unroll
            for (int t = 0; t < 4; ++t) acc[t] = __builtin_amdgcn_mfma_f32_16x16x32_bf16(*(const LAS bf16x8*)(W2T + (kv * 64 + 16 * t + r16) * 136 + 32 * s + 8 * kq), yb, acc[t], 0, 0, 0); }
        { bf16* dst = (kv == 0 ? F.KC16 : F.VCT16) + ((size_t)sh * 128 + 16 * w + r16) * 64 + 4 * kq;
#pragma unroll
          for (int t = 0; t < 4; ++t) *(u32x2*)(dst + 16 * t) = (u32x2){pk2(acc[t][0], acc[t][1]), pk2(acc[t][2], acc[t][3])}; }
        __syncthreads();
    }
}

#define MFMA32(a, b, c) __builtin_amdgcn_mfma_f32_32x32x16_bf16((a), (b), (c), 0, 0, 0)
struct AState { float m, l; f32x16 o0, o1; };
DI f32x16 zero16() { f32x16 z;
#pragma unroll
    for (int i = 0; i < 16; ++i) z[i] = 0.f; return z; }
DI void astate_init(AState& s) { s.m = -1e30f; s.l = 0.f; s.o0 = zero16(); s.o1 = zero16(); }
DI f32x16 qk_tile32(const LAS bf16* Kt, int KP, const bf16x8 (&qf)[4], int r, int h) {
    f32x16 acc = zero16();
#pragma unroll
    for (int s = 0; s < 4; ++s) { const bf16x8 kf = *(const LAS bf16x8*)(Kt + r * KP + 16 * s + 8 * h); acc = MFMA32(kf, qf[s], acc); }
    return acc;
}
typedef short v4i16_t __attribute__((ext_vector_type(4)));
DI s16x4 lds_tr(const LAS bf16* p) { return __builtin_bit_cast(s16x4, __builtin_amdgcn_ds_read_tr16_b64_v4i16((LAS v4i16_t*)p)); }
DI void pv_tile32(f32x16& o0, f32x16& o1, const LAS bf16* Vr, int VP, const f32x16& p, int lane) {
    const int h = lane >> 5, blk = (lane >> 4) & 1, q = (lane & 15) >> 2, pp = lane & 3;
    const LAS bf16* base = Vr + (4 * h + q) * VP + 16 * blk + 4 * pp;
#pragma unroll
    for (int s = 0; s < 2; ++s) {
        u32x4 pw; pw.x = pk2(p[8 * s], p[8 * s + 1]); pw.y = pk2(p[8 * s + 2], p[8 * s + 3]); pw.z = pk2(p[8 * s + 4], p[8 * s + 5]); pw.w = pk2(p[8 * s + 6], p[8 * s + 7]);
        const bf16x8 pf = __builtin_bit_cast(bf16x8, pw);
        { const s16x4 lo = lds_tr(base + 16 * s * VP), hi = lds_tr(base + (16 * s + 8) * VP);
          o0 = MFMA32(__builtin_shufflevector(lo, hi, 0, 1, 2, 3, 4, 5, 6, 7), pf, o0); }
        { const s16x4 lo = lds_tr(base + 16 * s * VP + 32), hi = lds_tr(base + (16 * s + 8) * VP + 32);
          o1 = MFMA32(__builtin_shufflevector(lo, hi, 0, 1, 2, 3, 4, 5, 6, 7), pf, o1); }
    }
}
DI float xhalf_max(float v) { return fmaxf(v, __shfl_xor(v, 32)); }
DI float xhalf_sum(float v) { return v + __shfl_xor(v, 32); }
DI void block_online(AState& st, const LAS bf16* Kt, int KP, const LAS bf16* Vt, int VP, const bf16x8 (&qf)[4], int kbase, int lo, int hi, bool flag, int r, int h) {
    const bool any = flag && (kbase + 63 >= lo) && (kbase <= hi);
    if (__ballot(any) == 0ull) return;
    f32x16 s0 = qk_tile32(Kt, KP, qf, r, h); __builtin_amdgcn_sched_barrier(0);
    f32x16 s1 = qk_tile32(Kt + 32 * KP, KP, qf, r, h); __builtin_amdgcn_sched_barrier(0);
    const bool cut = flag && !((kbase >= lo) && (kbase + 63 <= hi));
    float mx = -__builtin_inff();
    if (__ballot(cut) != 0ull) {
        const unsigned t0 = (unsigned)(kbase + 4 * h - lo), range = (unsigned)(hi - lo);
#pragma unroll
        for (int reg = 0; reg < 16; ++reg) { const unsigned o = (unsigned)((reg & 3) + 8 * (reg >> 2));
            s0[reg] = (t0 + o <= range) ? s0[reg] : -__builtin_inff(); s1[reg] = (t0 + 32u + o <= range) ? s1[reg] : -__builtin_inff(); mx = fmaxf(mx, fmaxf(s0[reg], s1[reg])); }
    } else {
#pragma unroll
        for (int reg = 0; reg < 16; ++reg) mx = fmaxf(mx, fmaxf(s0[reg], s1[reg]));
    }
    mx = any ? mx : -__builtin_inff();
    mx = xhalf_max(mx);
    const float mn = fmaxf(st.m, mx);
    if (__ballot(mx > st.m) != 0ull) {
        const float alpha = fexp2((st.m - mn) * LOG2E);
        st.l = st.l * alpha; st.o0 = st.o0 * alpha; st.o1 = st.o1 * alpha; st.m = mn;
    }
    const float bias = any ? -mn * LOG2E : -__builtin_inff();
    float sum = 0.f;
#pragma unroll
    for (int reg = 0; reg < 16; ++reg) { s0[reg] = fexp2(__builtin_fmaf(s0[reg], LOG2E, bias)); s1[reg] = fexp2(__builtin_fmaf(s1[reg], LOG2E, bias)); sum += s0[reg] + s1[reg]; }
    st.l += xhalf_sum(sum);
    __builtin_amdgcn_sched_barrier(0);
    pv_tile32(st.o0, st.o1, Vt, VP, s0, r + 32 * h);
    __builtin_amdgcn_sched_barrier(0);
    pv_tile32(st.o0, st.o1, Vt + 32 * VP, VP, s1, r + 32 * h);
}
DI void tile_online(AState& st, const LAS bf16* Kt, int KP, const LAS bf16* Vt, int VP, const bf16x8 (&qf)[4], int kbase, int lo, int hi, bool flag, int r, int h) {
    const bool any = flag && (kbase + 31 >= lo) && (kbase <= hi);
    if (__ballot(any) == 0ull) return;
    f32x16 s = qk_tile32(Kt, KP, qf, r, h);
    const bool cut = flag && !((kbase >= lo) && (kbase + 31 <= hi));
    float mx = -__builtin_inff();
    if (__ballot(cut) != 0ull) {
        const unsigned t0 = (unsigned)(kbase + 4 * h - lo), range = (unsigned)(hi - lo);
#pragma unroll
        for (int reg = 0; reg < 16; ++reg) { s[reg] = (t0 + (unsigned)((reg & 3) + 8 * (reg >> 2)) <= range) ? s[reg] : -__builtin_inff(); mx = fmaxf(mx, s[reg]); }
    } else {
#pragma unroll
        for (int reg = 0; reg < 16; ++reg) mx = fmaxf(mx, s[reg]);
    }
    mx = any ? mx : -__builtin_inff();
    mx = xhalf_max(mx);
    if (__ballot(mx > st.m + 5.5f) != 0ull) {
        const float mn2 = fmaxf(st.m, mx), alpha = fexp2((st.m - mn2) * LOG2E);
        st.l = st.l * alpha; st.o0 = st.o0 * alpha; st.o1 = st.o1 * alpha; st.m = mn2;
    }
    const float mn = st.m;
    const float bias = any ? -mn * LOG2E : -__builtin_inff();
    f32x2 sum2 = {0.f, 0.f}; const f32x2 b2 = {bias, bias}, l2 = {LOG2E, LOG2E};
#pragma unroll
    for (int reg = 0; reg < 16; reg += 2) { f32x2 t = {s[reg], s[reg + 1]}; t = __builtin_elementwise_fma(t, l2, b2);
        t[0] = fexp2(t[0]); t[1] = fexp2(t[1]); s[reg] = t[0]; s[reg + 1] = t[1]; sum2 = sum2 + t; }
    st.l += xhalf_sum(sum2[0] + sum2[1]);
    pv_tile32(st.o0, st.o1, Vt, VP, s, r + 32 * h);
}

constexpr int KTP = 72, VTP = 72;
struct StageRegs { u32x4 k, v; };
DI StageRegs stage_load(const bf16* kp, const bf16* vp, int tid) { StageRegs g; g.k = *(const u32x4*)(kp + tid * 8); g.v = *(const u32x4*)(vp + tid * 8); return g; }
DI void stage_store(LAS bf16* KT, LAS bf16* VT, const StageRegs& g, int tid) {
    *(LAS u32x4*)(KT + (tid >> 3) * KTP + (tid & 7) * 8) = g.k; *(LAS u32x4*)(VT + (tid >> 3) * VTP + (tid & 7) * 8) = g.v;
}
DI unsigned select_blocks_wave(LAS float* SC, LAS float* SCI, int lane, int tpos_base, int cur_of_tok0, bool sample) {
    const int tok = lane >> 3, sub = lane & 7;
    const int tpos = tpos_base + tok;
    const int cur = sample ? 32 : (tpos >> 6);
    (void)cur_of_tok0;
    LAS unsigned* SCU = (LAS unsigned*)SCI;
    unsigned long long my[4];
#pragma unroll
    for (int i = 0; i < 4; ++i) { const int s = 4 * sub + i; float v = 0.f;
#pragma unroll
        for (int g = 0; g < 4; ++g) v += SC[(4 * tok + g) * 33 + s] * SC[32 * 33 + 4 * tok + g];
        const bool started = (64 * s <= tpos), forced = (s == 0) || (s == cur) || (s == cur - 1);
        const float sc = started ? (forced ? 1e9f : v) : -1e9f;
        const unsigned bits = __builtin_bit_cast(unsigned, sc), key = (bits & 0x80000000u) ? ~bits : (bits | 0x80000000u);
        SCU[tok * 33 + s] = key; my[i] = ((unsigned long long)key << 5) | (unsigned)(31 - s); }
    __syncthreads();
    unsigned bits = 0u;
    int rank[4];
#pragma unroll
    for (int i = 0; i < 4; ++i) rank[i] = sample ? 1 : 0;
#pragma unroll 8
    for (int sp = 0; sp < 32; ++sp) { const unsigned long long o = ((unsigned long long)SCU[tok * 33 + sp] << 5) | (unsigned)(31 - sp);
#pragma unroll
        for (int i = 0; i < 4; ++i) rank[i] += (o > my[i]) ? 1 : 0; }
    const unsigned long long kmin = ((unsigned long long)0x4E6E6B28u) << 5;
    (void)kmin;
#pragma unroll
    for (int i = 0; i < 4; ++i) { const int s = 4 * sub + i; if (rank[i] < 16 && (64 * s <= tpos)) bits |= 1u << s; }
    bits |= __shfl_xor(bits, 1); bits |= __shfl_xor(bits, 2); bits |= __shfl_xor(bits, 4);
    return __shfl(bits, 8 * ((lane & 31) >> 2));
}

DI void nsa_prompt_unit(Frame& F, int b, int kv, int c) {
    LAS bf16* KT0 = (LAS bf16*)(F.lds), *VT0 = (LAS bf16*)(F.lds + 9216), *KT1 = (LAS bf16*)(F.lds + 18432), *VT1 = (LAS bf16*)(F.lds + 27648);
    LAS float* SC = (LAS float*)(F.lds + 36864 + F.wave * 4480); LAS float* SCI = (LAS float*)(F.lds + 72704 + F.wave * 1056);
    int tid_ = F.tid; asm volatile("" : "+v"(tid_));
    const int tid = tid_, lane = tid & 63, w = F.wave, r = lane & 31, h = lane >> 5;
    const int tok = 64 * c + 8 * w + (r >> 2), g = r & 3, head = kv * 4 + g, qpos = tok;
    const size_t row = (size_t)b * TT + tok;
    bf16x8 qf[4];
#pragma unroll
    for (int s = 0; s < 4; ++s) qf[s] = *(const bf16x8*)(F.NQ + row * 1024 + head * 64 + 16 * s + 8 * h);
    f32x16 out0, out1;
    const float gx0 = F.EXTRA[row * 64 + 16 + head * 3], gx1 = F.EXTRA[row * 64 + 16 + head * 3 + 1], gx2 = F.EXTRA[row * 64 + 16 + head * 3 + 2];
    __syncthreads();
    unsigned selmask;
    {
        const bf16* kc = F.KC16 + ((size_t)(NDB + b) * 4 + kv) * 128 * 64; const bf16* vc = F.VCT16 + ((size_t)(NDB + b) * 4 + kv) * 128 * 64;
        { const StageRegs a = stage_load(kc, vc, tid), bq = stage_load(kc + 64 * 64, vc + 64 * 64, tid); stage_store(KT0, VT0, a, tid); stage_store(KT1, VT1, bq, tid); }
        __syncthreads();
        int hin = (qpos - 31) >> 4; hin = hin > 126 ? 126 : hin;
        float mx = -1e30f;
#pragma unroll
        for (int q = 0; q < 4; ++q) { const f32x16 sq = qk_tile32((q < 2 ? KT0 : KT1) + (q & 1) * 32 * KTP, KTP, qf, r, h);
#pragma unroll
            for (int reg = 0; reg < 16; ++reg) { const int n = 32 * q + 4 * h + (reg & 3) + 8 * (reg >> 2); mx = fmaxf(mx, (n <= hin) ? sq[reg] : -1e30f); }
            __builtin_amdgcn_sched_barrier(0); }
        mx = fmaxf(mx, __shfl_xor(mx, 32));
        float sum = 0.f; float edge[16];
        f32x16 o0 = zero16(), o1 = zero16();
#pragma unroll
        for (int q = 0; q < 4; ++q) { f32x16 pq = qk_tile32((q < 2 ? KT0 : KT1) + (q & 1) * 32 * KTP, KTP, qf, r, h);
#pragma unroll
            for (int reg = 0; reg < 16; ++reg) { const int n = 32 * q + 4 * h + (reg & 3) + 8 * (reg >> 2); pq[reg] = (n <= hin) ? fexp2((pq[reg] - mx) * LOG2E) : 0.f; sum += pq[reg]; }
#pragma unroll
            for (int gq = 0; gq < 4; ++gq) { SC[r * 33 + 8 * q + 2 * gq + h] = (pq[4 * gq] + pq[4 * gq + 1]) + (pq[4 * gq + 2] + pq[4 * gq + 3]); edge[4 * q + gq] = pq[4 * gq + 3]; }
            pv_tile32(o0, o1, (q < 2 ? VT0 : VT1) + (q & 1) * 32 * VTP, VTP, pq, lane);
            __builtin_amdgcn_sched_barrier(0); }
        sum += __shfl_xor(sum, 32);
        const float inv = sum > 0.f ? 1.f / sum : 0.f;
        __syncthreads();
#pragma unroll
        for (int q = 0; q < 4; ++q)
#pragma unroll
            for (int gq = 0; gq < 4; ++gq) SC[r * 33 + 8 * q + 2 * gq + h + 1] += edge[4 * q + gq];
        if (h == 0) SC[32 * 33 + r] = inv;
        const float g0 = sigmoidf_(gx0) * inv;
        out0 = o0 * g0; out1 = o1 * g0;
        __syncthreads();
#ifndef CUT_SEL
        selmask = select_blocks_wave(SC, SCI, lane, 64 * c + 8 * w, c, false);
#else
        selmask = SC[lane];
#endif
    }
    LAS float* OUTW = (LAS float*)(F.lds + 36864) + w * 2048 + lane;
    __syncthreads();
#pragma unroll
    for (int i = 0; i < 16; ++i) { OUTW[i * 64] = out0[i]; OUTW[(16 + i) * 64] = out1[i]; }
#pragma unroll
    for (int s = 0; s < 4; ++s) qf[s] = *(const bf16x8*)(F.NQ + row * 1024 + head * 64 + 16 * s + 8 * h);
#ifndef CUT_SLC
    {
        AState st; astate_init(st);
        int tid2 = tid; asm volatile("" : "+v"(tid2));
        const bf16* kb = F.KB16 + ((size_t)(0 * NB * 4 + b * 4 + kv) * TT) * 64; const bf16* vb = F.VT16 + ((size_t)(0 * NB * 4 + b * 4 + kv) * TT) * 64;
        StageRegs g0 = stage_load(kb, vb, tid2), g1 = g0;
        if (c >= 1) g1 = stage_load(kb + (size_t)64 * 64, vb + (size_t)64 * 64, tid2);
#pragma unroll 1
        for (int j = 0; j <= c; j += 2) {
            const bool two = (j + 1 <= c);
            __syncthreads();
            stage_store(KT0, VT0, g0, tid2); if (two) stage_store(KT1, VT1, g1, tid2);
            __syncthreads();
            if (j + 2 <= c) g0 = stage_load(kb + (size_t)(j + 2) * 64 * 64, vb + (size_t)(j + 2) * 64 * 64, tid2);
            if (j + 3 <= c) g1 = stage_load(kb + (size_t)(j + 3) * 64 * 64, vb + (size_t)(j + 3) * 64 * 64, tid2);
            { const bool fl = (selmask >> j) & 1u;
              tile_online(st, KT0, KTP, VT0, VTP, qf, 64 * j, 0, qpos, fl, r, h);
              tile_online(st, KT0 + 32 * KTP, KTP, VT0 + 32 * VTP, VTP, qf, 64 * j + 32, 0, qpos, fl, r, h);
              __builtin_amdgcn_sched_barrier(0); }
            if (two) { const bool fl = (selmask >> (j + 1)) & 1u;
              tile_online(st, KT1, KTP, VT1, VTP, qf, 64 * j + 64, 0, qpos, fl, r, h);
              tile_online(st, KT1 + 32 * KTP, KTP, VT1 + 32 * VTP, VTP, qf, 64 * j + 96, 0, qpos, fl, r, h);
              __builtin_amdgcn_sched_barrier(0); }
        }
        int l2 = lane; asm volatile("" : "+v"(l2));
        const int r2 = l2 & 31; const size_t row2 = (size_t)b * TT + 64 * c + 8 * w + (r2 >> 2);
        const float sc = sigmoidf_(gx1) * (st.l > 0.f ? 1.f / st.l : 0.f);
#pragma unroll
        for (int i = 0; i < 16; ++i) { OUTW[i * 64] += st.o0[i] * sc; OUTW[(16 + i) * 64] += st.o1[i] * sc; }
    }
#endif
#ifndef CUT_WIN
    {
        AState st; astate_init(st);
        const int jlo = c >= 8 ? c - 8 : 0;
        int tid3 = tid; asm volatile("" : "+v"(tid3));
        const bf16* kb = F.KB16 + ((size_t)(1 * NB * 4 + b * 4 + kv) * TT) * 64; const bf16* vb = F.VT16 + ((size_t)(1 * NB * 4 + b * 4 + kv) * TT) * 64;
        StageRegs g0 = stage_load(kb + (size_t)jlo * 64 * 64, vb + (size_t)jlo * 64 * 64, tid3), g1 = g0;
        if (jlo + 1 <= c) g1 = stage_load(kb + (size_t)(jlo + 1) * 64 * 64, vb + (size_t)(jlo + 1) * 64 * 64, tid3);
#pragma unroll 1
        for (int j = jlo; j <= c; j += 2) {
            const bool two = (j + 1 <= c);
            __syncthreads();
            stage_store(KT0, VT0, g0, tid3); if (two) stage_store(KT1, VT1, g1, tid3);
            __syncthreads();
            if (j + 2 <= c) g0 = stage_load(kb + (size_t)(j + 2) * 64 * 64, vb + (size_t)(j + 2) * 64 * 64, tid3);
            if (j + 3 <= c) g1 = stage_load(kb + (size_t)(j + 3) * 64 * 64, vb + (size_t)(j + 3) * 64 * 64, tid3);
            tile_online(st, KT0, KTP, VT0, VTP, qf, 64 * j, qpos - 511, qpos, true, r, h);
            tile_online(st, KT0 + 32 * KTP, KTP, VT0 + 32 * VTP, VTP, qf, 64 * j + 32, qpos - 511, qpos, true, r, h);
            if (two) {
              tile_online(st, KT1, KTP, VT1, VTP, qf, 64 * j + 64, qpos - 511, qpos, true, r, h);
              tile_online(st, KT1 + 32 * KTP, KTP, VT1 + 32 * VTP, VTP, qf, 64 * j + 96, qpos - 511, qpos, true, r, h);
              __builtin_amdgcn_sched_barrier(0); }
        }
        int l2 = lane; asm volatile("" : "+v"(l2));
        const int r2 = l2 & 31; const size_t row2 = (size_t)b * TT + 64 * c + 8 * w + (r2 >> 2);
        const float sc = sigmoidf_(gx2) * (st.l > 0.f ? 1.f / st.l : 0.f);
#pragma unroll
        for (int i = 0; i < 16; ++i) { out0[i] = OUTW[i * 64] + st.o0[i] * sc; out1[i] = OUTW[(16 + i) * 64] + st.o1[i] * sc; }
    }
#endif
    int l3 = lane; asm volatile("" : "+v"(l3));
    const int r3 = l3 & 31, h3 = l3 >> 5; const size_t row3 = (size_t)b * TT + 64 * c + 8 * w + (r3 >> 2);
    bf16* mp = F.MIX + row3 * DM + 1024 + (kv * 4 + (r3 & 3)) * 64;
#pragma unroll
    for (int gq = 0; gq < 4; ++gq) {
        u32x2 a; a.x = pk2(out0[4 * gq], out0[4 * gq + 1]); a.y = pk2(out0[4 * gq + 2], out0[4 * gq + 3]); *(u32x2*)(mp + 8 * gq + 4 * h3) = a;
        u32x2 bq; bq.x = pk2(out1[4 * gq], out1[4 * gq + 1]); bq.y = pk2(out1[4 * gq + 2], out1[4 * gq + 3]); *(u32x2*)(mp + 32 + 8 * gq + 4 * h3) = bq;
    }
    __syncthreads();
}

constexpr int SKP = 72, SVP = 72;
struct SampRegs { f32x4 kx[8], vx[8]; unsigned ok; };
template <class RowPtr>
DI void sample_issue(SampRegs& R, const RowPtr& rp, const float* dummy, int tid_in) {
    int tid = tid_in; asm volatile("" : "+v"(tid));
    const int krow = tid >> 4, piece = tid & 15;
    R.ok = 0u;
#pragma unroll
    for (int p = 0; p < 8; ++p) { const float* sp = rp(32 * p + krow); R.ok |= (sp ? 1u : 0u) << p; const float* a = (sp ? sp : dummy) + 4 * piece;
        R.kx[p] = __builtin_nontemporal_load((const f32x4*)a); R.vx[p] = __builtin_nontemporal_load((const f32x4*)(a + 256)); }
}
DI void sample_commit(LAS bf16* KT, LAS bf16* VT, const SampRegs& R, int tid_in) {
    int tid = tid_in; asm volatile("" : "+v"(tid));
    const int krow = tid >> 4, piece = tid & 15;
#pragma unroll
    for (int p = 0; p < 8; ++p) { const int key = 32 * p + krow; const bool ok = (R.ok >> p) & 1u; const f32x4 a = ok ? R.kx[p] : (f32x4){0.f, 0.f, 0.f, 0.f}, b = ok ? R.vx[p] : (f32x4){0.f, 0.f, 0.f, 0.f};
        *(LAS u32x2*)(KT + key * SKP + 4 * piece) = (u32x2){pk2(a[0], a[1]), pk2(a[2], a[3])};
        *(LAS u32x2*)(VT + key * SVP + 4 * piece) = (u32x2){pk2(b[0], b[1]), pk2(b[2], b[3])}; }
}
struct SlcRows { const float* c_slc; const float* newrows; const LAS int* ptab; unsigned uni; int db, kv, sb;
    DI const float* operator()(int key) const {
        if (sb < 8) { const int j = 4 * sb + (key >> 6); if (!((uni >> j) & 1u)) return nullptr; const int page = ptab[j >> 1];
            return c_slc + ((size_t)page * 128 + (j & 1) * 64 + (key & 63)) * 512 + kv * 64; }
        return key < 8 ? newrows + ((size_t)db * 8 + key) * 512 + kv * 64 : nullptr; } };
struct WinRows { const float* c_win; const float* newrows; int db, kv, sb;
    DI const float* operator()(int key) const {
        if (sb < 2) return c_win + ((size_t)db * 512 + 256 * sb + key) * 512 + kv * 64;
        return key < 8 ? newrows + ((size_t)db * 512 + 504 + key) * 512 + kv * 64 : nullptr; } };
DI void sample_merge(Frame& F, LAS float* XM, LAS float* XL, const float mw, const float lw, const f32x16& o0, const f32x16& o1, float gate, f32x4& fin, int w, int r, int h) {
    LAS float* RED = (LAS float*)F.lds;
    __syncthreads();
    if (h == 0) { XM[w * 32 + r] = mw; XL[w * 32 + r] = lw; }
    __syncthreads();
    float m = -1e30f;
#pragma unroll
    for (int i = 0; i < 8; ++i) m = fmaxf(m, XM[i * 32 + r]);
    float l = 0.f;
#pragma unroll
    for (int i = 0; i < 8; ++i) l += XL[i * 32 + r] * fexp2((XM[i * 32 + r] - m) * LOG2E);
    const float f = (l > 0.f) ? gate * fexp2((mw - m) * LOG2E) / l : 0.f;
#pragma unroll
    for (int reg = 0; reg < 16; ++reg) { const int d = (reg & 3) + 8 * (reg >> 2) + 4 * h; RED[(w * 32 + r) * 64 + d] = o0[reg] * f; RED[(w * 32 + r) * 64 + 32 + d] = o1[reg] * f; }
    __syncthreads();
    { const int q = F.tid >> 4, d4 = (F.tid & 15) * 4;
#pragma unroll
      for (int i = 0; i < 8; ++i) fin = fin + *(const LAS f32x4*)(RED + (i * 32 + q) * 64 + d4); }
    __syncthreads();
}
DI void nsa_sample_unit(Frame& F, int db, int kv) {
    LAS bf16* KT = (LAS bf16*)(F.lds), *VT = (LAS bf16*)(F.lds + 36864);
    LAS float *SC = (LAS float*)(F.lds + 73728), *SCI = (LAS float*)(F.lds + 78208), *XM = (LAS float*)(F.lds + 79264), *XL = (LAS float*)(F.lds + 80288);
    LAS unsigned* SMASK = (LAS unsigned*)(F.lds + 81312); LAS int* PT = (LAS int*)(F.lds + 81408);
    int tid_ = F.tid; asm volatile("" : "+v"(tid_));
    const int tid = tid_, lane = tid & 63, w = F.wave, r = lane & 31, h = lane >> 5;
    const int ts = r >> 2, g = r & 3, head = kv * 4 + g, qpos = TT + ts;
    const size_t row = (size_t)MP + db * 8 + ts;
    bf16x8 qf[4];
#pragma unroll
    for (int s = 0; s < 4; ++s) qf[s] = *(const bf16x8*)(F.NQ + row * 1024 + head * 64 + 16 * s + 8 * h);
    const float* gp = F.EXTRA + row * 64 + 16 + head * 3;
    const float g0 = sigmoidf_(gp[0]), g1 = sigmoidf_(gp[1]), g2 = sigmoidf_(gp[2]);
    f32x4 fin = {0.f, 0.f, 0.f, 0.f};
    __syncthreads();
    if (tid < 16) PT[tid] = F.ptab[db * 16 + tid];
    {
        const bf16* kc = F.KC16 + ((size_t)db * 4 + kv) * 128 * 64; const bf16* vc = F.VCT16 + ((size_t)db * 4 + kv) * 128 * 64;
#pragma unroll
        for (int q = 0; q < 2; ++q) { const int e = tid + 512 * q;
            *(LAS u32x4*)(KT + (e >> 3) * SKP + (e & 7) * 8) = *(const u32x4*)(kc + e * 8); *(LAS u32x4*)(VT + (e >> 3) * SVP + (e & 7) * 8) = *(const u32x4*)(vc + e * 8); }
        __syncthreads();
        f32x16 p = zero16(); float mw = -1e30f, lw = 0.f;
        if (w < 4) {
            p = qk_tile32(KT + 32 * w * SKP, SKP, qf, r, h);
#pragma unroll
            for (int reg = 0; reg < 16; ++reg) { const int n = 32 * w + 4 * h + (reg & 3) + 8 * (reg >> 2); p[reg] = (n <= 126) ? p[reg] : -1e30f; mw = fmaxf(mw, p[reg]); }
            mw = fmaxf(mw, __shfl_xor(mw, 32));
#pragma unroll
            for (int reg = 0; reg < 16; ++reg) { p[reg] = (p[reg] > -1e29f) ? fexp2((p[reg] - mw) * LOG2E) : 0.f; lw += p[reg]; }
            lw += __shfl_xor(lw, 32);
        }
        if (h == 0) { XM[w * 32 + r] = mw; XL[w * 32 + r] = lw; }
        __syncthreads();
        float m = -1e30f;
#pragma unroll
        for (int i = 0; i < 8; ++i) m = fmaxf(m, XM[i * 32 + r]);
        float l = 0.f;
#pragma unroll
        for (int i = 0; i < 8; ++i) l += XL[i * 32 + r] * fexp2((XM[i * 32 + r] - m) * LOG2E);
        const float f = (l > 0.f) ? fexp2((mw - m) * LOG2E) / l : 0.f;
        p = p * f;
        if (w < 4) {
#pragma unroll
            for (int gq = 0; gq < 4; ++gq) SC[r * 33 + 8 * w + 2 * gq + h] = (p[4 * gq] + p[4 * gq + 1]) + (p[4 * gq + 2] + p[4 * gq + 3]);
        }
        if (w == 4 && h == 0) SC[32 * 33 + r] = 1.f;
        __syncthreads();
        f32x16 o0 = zero16(), o1 = zero16();
        if (w < 4) {
#pragma unroll
            for (int gq = 0; gq < 4; ++gq) SC[r * 33 + 8 * w + 2 * gq + h + 1] += p[4 * gq + 3];
            pv_tile32(o0, o1, VT + 32 * w * SVP, SVP, p, lane);
        }
        __syncthreads();
        unsigned bits = select_blocks_wave(SC, SCI, lane, TT, 32, true);
        if (w == 0 && lane < 32 && (lane & 3) == 0) SMASK[lane >> 2] = bits;
        sample_merge(F, XM, XL, 0.f, (w == 0) ? 1.f : 0.f, o0, o1, g0, fin, w, r, h);
    }
    const unsigned selmask = SMASK[ts];
    unsigned uni = 0u;
#pragma unroll
    for (int i = 0; i < 8; ++i) uni |= SMASK[i];
    {
        AState st; astate_init(st);
        SampRegs R;
        { const SlcRows rp{F.c_slc, F.out + O_SLCS, PT, uni, db, kv, 0}; sample_issue(R, rp, F.c_win, tid); }
#pragma unroll 1
        for (int sb = 0; sb < 9; ++sb) {
            __syncthreads();
            sample_commit(KT, VT, R, tid);
            __syncthreads();
            if (sb + 1 < 9) { const SlcRows rp{F.c_slc, F.out + O_SLCS, PT, uni, db, kv, sb + 1}; sample_issue(R, rp, F.c_win, tid); }
            const int j = 4 * sb + (w >> 1);
            const bool fl = (j >= 32) ? true : ((selmask >> j) & 1u);
            tile_online(st, KT + 32 * w * SKP, SKP, VT + 32 * w * SVP, SVP, qf, 256 * sb + 32 * w, 0, qpos, fl, r, h);
        }
        sample_merge(F, XM, XL, st.m, st.l, st.o0, st.o1, g1, fin, w, r, h);
    }
    {
        AState st; astate_init(st);
        SampRegs R;
        { const WinRows rp{F.c_win, F.out + O_WINS, db, kv, 0}; sample_issue(R, rp, F.c_win, tid); }
#pragma unroll 1
        for (int sb = 0; sb < 3; ++sb) {
            __syncthreads();
            sample_commit(KT, VT, R, tid);
            __syncthreads();
            if (sb + 1 < 3) { const WinRows rp{F.c_win, F.out + O_WINS, db, kv, sb + 1}; sample_issue(R, rp, F.c_win, tid); }
            tile_online(st, KT + 32 * w * SKP, SKP, VT + 32 * w * SVP, SVP, qf, (TT - 512) + 256 * sb + 32 * w, qpos - 511, qpos, true, r, h);
        }
        sample_merge(F, XM, XL, st.m, st.l, st.o0, st.o1, g2, fin, w, r, h);
    }
    { const int q = tid >> 4, d4 = (tid & 15) * 4;
      u32x2 wv; wv.x = pk2(fin[0], fin[1]); wv.y = pk2(fin[2], fin[3]);
      *(u32x2*)(F.MIX + ((size_t)MP + db * 8 + (q >> 2)) * DM + 1024 + (kv * 4 + (q & 3)) * 64 + d4) = wv; }
    __syncthreads();
}

#ifndef MK_ONE_LAUNCH
#define MK_ONE_LAUNCH 1
#endif
constexpr int NPHASE = 13;
#ifndef GEMM_SP2
#define GEMM_SP2 true
#endif
#ifndef GEMM_ALIGN
#define GEMM_ALIGN true
#endif
struct Args { const void* in[21]; float* out; unsigned char* ws; int ph_lo, ph_hi; };
static_assert(sizeof(Args) == 21 * 8 + 8 + 8 + 8, "Args has no padding");

__global__ void __launch_bounds__(NWAVES * 64, 2) hybrid_fwd(Args args) {
    extern __shared__ __attribute__((aligned(16))) unsigned char lds[];
    Frame F;
    F.lds = (LAS unsigned char*)lds;
    F.MISC = (volatile LAS unsigned*)(F.lds + MISC_OFF);
    F.tid = threadIdx.x; F.lane = F.tid & 63; F.wave = __builtin_amdgcn_readfirstlane(F.tid >> 6);
    F.G = gridDim.x; { const int bx = blockIdx.x; F.vcu = (F.G % 8 == 0) ? (bx % 8) * (F.G / 8) + bx / 8 : bx; }
    unsigned char* ws = args.ws;
    F.ctl = (gu32*)(ws + WS_CTL);
    F.out = args.out;
    F.x_p = (const float*)args.in[0]; F.x_s = (const float*)args.in[1]; F.c_cmp = (const float*)args.in[2]; F.c_slc = (const float*)args.in[3]; F.c_win = (const float*)args.in[4];
    F.st_gla = (const float*)args.in[5]; F.ptab = (const int*)args.in[6]; F.w1a = (const float*)args.in[7]; F.w1b = (const float*)args.in[8]; F.w_in = (const float*)args.in[9];
    F.w_g2 = (const float*)args.in[10]; F.b_g2 = (const float*)args.in[11]; F.gnorm = (const float*)args.in[12]; F.cpos = (const float*)args.in[13]; F.cw1 = (const float*)args.in[14];
    F.cw2 = (const float*)args.in[15]; F.w_out = (const float*)args.in[16]; F.w2a = (const float*)args.in[17]; F.w2b = (const float*)args.in[18]; F.ln_g = (const float*)args.in[19]; F.ln_b = (const float*)args.in[20];
    F.CBIAS = (float*)(ws + WS_SMALL);
    F.W1A = (bf16*)(ws + WS_W1A); F.W1B = (bf16*)(ws + WS_W1B); F.WIN = (bf16*)(ws + WS_WIN); F.WOUT = (bf16*)(ws + WS_WOUT); F.W2A = (bf16*)(ws + WS_W2A); F.W2B = (bf16*)(ws + WS_W2B);
    F.CW1 = (bf16*)(ws + WS_CW1); F.XB = (bf16*)(ws + WS_XB); F.HB = (bf16*)(ws + WS_HB); F.ZF = (float*)(ws + WS_ZF); F.G16 = (bf16*)(ws + WS_GLAIN); F.NQ = (bf16*)(ws + WS_NQ);
    F.EXTRA = (float*)(ws + WS_EXTRA); F.WINROWS = (float*)(ws + WS_WINROWS); F.ORAW = (float*)(ws + WS_ORAW); F.MIX = (bf16*)(ws + WS_MIX); F.XBLK = (bf16*)(ws + WS_XBLK);
    F.ZC = (float*)(ws + WS_ZC); F.KCMP = (float*)(ws + WS_KCMP);
    F.GQ = (bf16*)(ws + WS_GQ); F.GKT = (bf16*)(ws + WS_GKT); F.GA = (bf16*)(ws + WS_GA); F.GVT = (bf16*)(ws + WS_GVT); F.GD = (float*)(ws + WS_GD); F.SLAB = (float*)(ws + WS_SLAB);
    F.KB16 = (bf16*)(ws + WS_KB16); F.VT16 = (bf16*)(ws + WS_VT16); F.KC16 = (bf16*)(ws + WS_KC16); F.VCT16 = (bf16*)(ws + WS_VCT16);
    for (int u = F.tid; u < (LDS_BYTES - LDSCTL_OFF) / 4; u += NWAVES * 64) ((LAS unsigned*)(F.lds + LDSCTL_OFF))[u] = 0u;
    __syncthreads();
    const int lo = args.ph_lo, hi = args.ph_hi;
    XcdBarrier bar; bar.bar = (unsigned*)(F.ctl + CW_BAR); bar.x = 0; bar.st = nullptr;
    if (hi - lo > 1) bar = xcd_barrier_post((unsigned*)(F.ctl + CW_BAR), F.MISC + 8);
#ifndef PH_MASK
#define PH_MASK 0xFFFF
#endif
#define IN(k) (((PH_MASK >> (k)) & 1) && lo <= (k) && (k) < hi)
#define PH_BEGIN() do { int t_ = threadIdx.x; asm volatile("" : "+v"(t_)); F.tid = t_; F.lane = t_ & 63; F.wave = __builtin_amdgcn_readfirstlane(t_ >> 6); } while (0)
#define SEAM(k) do { if (IN(k) && IN((k) + 1)) xcd_barrier(bar); } while (0)
    const int bx = (int)blockIdx.x;

    if (IN(0)) { PH_BEGIN(); p0_prologue(F); } SEAM(0);
    if (IN(1)) { PH_BEGIN(); pg8::Gemm g{F.XB, F.W1A, MTOT, 2 * DFF, DM}; pg8::StaticOrder S; S.init(MTOT, 2 * DFF, F.G, bx); EpiSwiGLU E{F.HB};
        if (F.vcu & 1) { xblk_part(F, F.vcu, F.G); __syncthreads(); }
        pg8::gemm_phase<EpiSwiGLU, pg8::StaticOrder, GEMM_ALIGN, GEMM_SP2>(F.lds, g, S, E);
        if (!(F.vcu & 1)) { __syncthreads(); xblk_part(F, F.vcu, F.G); }
        late_tail(F, 1, bx, (MTOT / 256) * (2 * DFF / 256));
 } SEAM(1);
#ifndef REP_FFO
#define REP_FFO 1
#endif
#ifdef EXP_HOTA
    if (IN(2)) { struct HotOrder : pg8::StaticOrder { DI bool next(int i, pg8::Unit& u) const { const bool r = pg8::StaticOrder::next(i, u); u.pm = u.pm & 7; return r; } };
        pg8::Gemm g{F.HB, F.W1B, MP, DM, DFF, 0}; HotOrder S; S.init(MP, DM, F.G, bx); EpiResid E{F.x_p, (bf16*)F.ORAW, 0.5f};
        pg8::gemm_phase<EpiResid, HotOrder, true, GEMM_SP2>(F.lds, g, S, E); }
#endif
    if (IN(2)) { PH_BEGIN(); for (int rep = 0; rep < REP_FFO; ++rep) { pg8::Gemm g{F.HB, F.W1B, MP, DM, DFF, 0}; pg8::StaticOrder S; S.init(MP, DM, F.G, bx); EpiResid E{F.x_p, (bf16*)F.ZF, 0.5f};
          pg8::gemm_phase<EpiResid, pg8::StaticOrder, GEMM_ALIGN, GEMM_SP2>(F.lds, g, S, E); }
        { pg8::Gemm g{F.HB, F.W1B, MTOT, DM, DFF / NSPLIT, DFF}; SplitOrder S{F.G, bx, (DFF / NSPLIT) * 2}; EpiSlab E{F.SLAB, (DFF / NSPLIT) * 2};
          pg8::gemm_phase<EpiSlab, SplitOrder, GEMM_ALIGN, GEMM_SP2>(F.lds, g, S, E); }
        late_tail(F, 2, bx, 32 * NSPLIT); } SEAM(2);
    if (IN(3)) { PH_BEGIN(); ln_phase(F, (const bf16*)F.ZF, nullptr, F.XB, F.ln_g, F.ln_b, F.x_s, nullptr, 0.5f); } SEAM(3);
    if (IN(4)) { PH_BEGIN(); pg8::Gemm g{F.XB, F.WIN, MTOT, NIN, DM}; pg8::StaticOrder S; S.init(MTOT, NIN, F.G, bx); EpiInProj E{F.G16, F.NQ, F.out, F.WINROWS, F.XBLK, F.KB16, F.VT16};
#ifndef REP_EXTRA
#define REP_EXTRA 1
#endif
        if (F.vcu & 1) { for (int rep = 0; rep < REP_EXTRA; ++rep) extra_phase(F, F.G - 1 - bx, F.G); __syncthreads(); }
        pg8::gemm_phase<EpiInProj, pg8::StaticOrder, GEMM_ALIGN, GEMM_SP2>(F.lds, g, S, E);
        if (!(F.vcu & 1)) { __syncthreads(); for (int rep = 0; rep < REP_EXTRA; ++rep) extra_phase(F, F.G - 1 - bx, F.G); }
        late_tail(F, 4, bx, (MTOT / 256) * (NIN / 256)); } SEAM(4);
    if (IN(5)) { PH_BEGIN();
#ifndef REP_GPRE
#define REP_GPRE 1
#endif
#ifndef REP_GSMP
#define REP_GSMP 1
#endif
#ifndef REP_CGEMM
#define REP_CGEMM 1
#endif
#ifndef REP_GSEQ
#define REP_GSEQ 1
#endif
#ifndef REP_ZC
#define REP_ZC 1
#endif
        const bool gemm_first = (F.vcu & 1) != 0;
        if (gemm_first) { __syncthreads();
            for (int rep = 0; rep < REP_CGEMM; ++rep) { pg8::Gemm g{F.XBLK, F.CW1, 2 * XROWS, 512, 1024}; CmpOrder S{F.G, bx}; EpiZ E{(bf16*)F.ZC};
              pg8::gemm_phase<EpiZ, CmpOrder, GEMM_ALIGN, GEMM_SP2>(F.lds, g, S, E); }
            __syncthreads(); }
        for (int rep = 0; rep < REP_GPRE; ++rep) { PreRegs PR; if (F.vcu < NB * 4 * 32) { pre_load_qk(F, PR, F.vcu, F.tid); pre_load_v(F, PR, F.vcu, F.tid); }
            for (int it = F.vcu; it < NB * 4 * 32; it += F.G) gla_pre_item(F, it, PR, it + F.G < NB * 4 * 32 ? it + F.G : -1); }
        for (int rep = 0; rep < REP_GSMP; ++rep) for (int u = F.vcu; u < NDB * 4; u += F.G) gla_sample_unit(F, u >> 2, u & 3);
        __syncthreads();
        if (!gemm_first) {
            for (int rep = 0; rep < REP_CGEMM; ++rep) { pg8::Gemm g{F.XBLK, F.CW1, 2 * XROWS, 512, 1024}; CmpOrder S{F.G, bx}; EpiZ E{(bf16*)F.ZC};
              pg8::gemm_phase<EpiZ, CmpOrder, GEMM_ALIGN, GEMM_SP2>(F.lds, g, S, E); }
            __syncthreads(); }
        late_tail(F, 5, bx, 2 * (XROWS / 256));
    } SEAM(5);
    if (IN(6)) { PH_BEGIN();
        const int nseq = NB * 4 * 4;
        if (F.G == 2 * nseq) { const int u = F.vcu >> 1;
                               if ((F.vcu & 1) == 0) { for (int rep = 0; rep < REP_GSEQ; ++rep) gla_seq_unit(F, u >> 4, (u >> 2) & 3, u & 3); }
                               else { for (int rep = 0; rep < REP_ZC; ++rep) zcombine_phase(F, u, nseq); } }
        else { for (int u = F.vcu; u < nseq; u += F.G) gla_seq_unit(F, u >> 4, (u >> 2) & 3, u & 3); zcombine_phase(F, F.vcu, F.G); } } SEAM(6);
#ifdef EXP_BARS
    if (IN(6) && IN(7)) { for (int q = 0; q < 8; ++q) xcd_barrier(bar); }
#endif
    if (IN(7)) { PH_BEGIN();
#ifndef REP_NSAP
#define REP_NSAP 1
#endif
#ifndef REP_NSAS
#define REP_NSAS 1
#endif
#pragma unroll 1
        for (int half = 0; half < 2; ++half) {
            if ((half ^ (F.vcu & 1)) == 0) {
                for (int rep = 0; rep < REP_NSAP; ++rep)
                for (int U = F.vcu; U < 1024; U += F.G) { const int i = U >> 8, id = U & 255, bk = id >> 3, q = id & 7; const int c = i == 0 ? q : (i == 1 ? 15 - q : (i == 2 ? 16 + q : 31 - q));
                    nsa_prompt_unit(F, bk >> 2, bk & 3, c); }
            } else {
                for (int rep = 0; rep < REP_NSAS; ++rep)
                for (int u = F.vcu; u < NDB * 4; u += F.G) nsa_sample_unit(F, u >> 2, u & 3);
            }
        }
#ifndef REP_FIN
#define REP_FIN 1
#endif
        for (int rep = 0; rep < REP_FIN; ++rep) gla_finalize_phase(F);
    } SEAM(7);
    if (IN(8)) { PH_BEGIN(); { pg8::Gemm g{F.MIX, F.WOUT, MP, DM, DM, 0}; pg8::StaticOrder S; S.init(MP, DM, F.G, bx); EpiResid16 E{F.XB, (bf16*)F.ZF, 1.0f};
          pg8::gemm_phase<EpiResid16, pg8::StaticOrder, GEMM_ALIGN, GEMM_SP2>(F.lds, g, S, E); }
        { pg8::Gemm g{F.MIX, F.WOUT, MTOT, DM, DM / NSPLIT, DM}; SplitOrder S{F.G, bx, (DM / NSPLIT) * 2}; EpiSlab E{F.SLAB, (DM / NSPLIT) * 2};
          pg8::gemm_phase<EpiSlab, SplitOrder, GEMM_ALIGN, GEMM_SP2>(F.lds, g, S, E); }
        late_tail(F, 8, bx, 32 * NSPLIT); } SEAM(8);
    if (IN(9)) { PH_BEGIN(); ln_phase(F, (const bf16*)F.ZF, nullptr, F.XB, F.ln_g + DM, F.ln_b + DM, nullptr, F.XB + (size_t)MP * DM, 1.0f); } SEAM(9);
    if (IN(10)) { PH_BEGIN(); pg8::Gemm g{F.XB, F.W2A, MTOT, 2 * DFF, DM}; pg8::StaticOrder S; S.init(MTOT, 2 * DFF, F.G, bx); EpiSwiGLU E{F.HB};
        pg8::gemm_phase<EpiSwiGLU, pg8::StaticOrder, GEMM_ALIGN, GEMM_SP2>(F.lds, g, S, E);
        late_tail(F, 10, bx, (MTOT / 256) * (2 * DFF / 256)); } SEAM(10);
    if (IN(11)) { PH_BEGIN(); { pg8::Gemm g{F.HB, F.W2B, MP, DM, DFF, 0}; pg8::StaticOrder S; S.init(MP, DM, F.G, bx); EpiResid16 E{F.XB, (bf16*)F.ZF, 0.5f};
          pg8::gemm_phase<EpiResid16, pg8::StaticOrder, GEMM_ALIGN, GEMM_SP2>(F.lds, g, S, E); }
        { pg8::Gemm g{F.HB, F.W2B, MTOT, DM, DFF / NSPLIT, DFF}; SplitOrder S{F.G, bx, (DFF / NSPLIT) * 2}; EpiSlab E{F.SLAB, (DFF / NSPLIT) * 2};
          pg8::gemm_phase<EpiSlab, SplitOrder, GEMM_ALIGN, GEMM_SP2>(F.lds, g, S, E); }
        late_tail(F, 11, bx, 32 * NSPLIT); } SEAM(11);
    if (IN(12)) { PH_BEGIN(); ln_phase(F, (const bf16*)F.ZF, F.out, nullptr, F.ln_g + 2 * DM, F.ln_b + 2 * DM, nullptr, F.XB + (size_t)MP * DM, 0.5f); }
#undef IN
#undef SEAM
}

extern "C" void kernel_launch(void* const* d_in, const int* in_sizes, int n_in, void* d_out, int out_size, void* d_ws, size_t ws_size, hipStream_t stream) {
    static int grid = 0;
    if (grid == 0) {
        if (n_in != 21 || out_size != (int)O_END || ws_size < WS_END) { fprintf(stderr, "kernel_launch: unexpected shapes: n_in %d out %d ws %zu (need %zu)\n", n_in, out_size, ws_size, (size_t)WS_END); grid = -1; return; }
        int dev = 0, cus = 0;
        if (hipGetDevice(&dev) != hipSuccess || hipDeviceGetAttribute(&cus, hipDeviceAttributeMultiprocessorCount, dev) != hipSuccess) { grid = -1; return; }
        if (hipFuncSetAttribute((const void*)hybrid_fwd, hipFuncAttributeMaxDynamicSharedMemorySize, LDS_BYTES) != hipSuccess) { fprintf(stderr, "kernel_launch: hipFuncSetAttribute failed\n"); grid = -1; return; }
        int per_cu = 0;
        if (hipOccupancyMaxActiveBlocksPerMultiprocessor(&per_cu, (const void*)hybrid_fwd, NWAVES * 64, LDS_BYTES) != hipSuccess || per_cu < 1) fprintf(stderr, "kernel_launch: occupancy query says %d\n", per_cu);
        (void)hipGetLastError();
        grid = cus;
    }
    if (grid < 0) return;
    (void)in_sizes;
    if (hipMemsetAsync((char*)d_ws + WS_CTL, 0, CTL_ZERO_BYTES, stream) != hipSuccess) return;
    Args a{};
    for (int i = 0; i < 21; ++i) a.in[i] = d_in[i];
    a.out = (float*)d_out; a.ws = (unsigned char*)d_ws;
#if MK_ONE_LAUNCH
    a.ph_lo = 0; a.ph_hi = NPHASE;
    hipLaunchKernelGGL(hybrid_fwd, dim3(grid), dim3(NWAVES * 64), LDS_BYTES, stream, a);
#else
#ifndef PROBE_DBL
#define PROBE_DBL 0
#endif
    for (int p = 0; p < NPHASE; ++p) { a.ph_lo = p; a.ph_hi = p + 1;
        for (int rep = 0; rep < 1 + ((PROBE_DBL >> p) & 1); ++rep) hipLaunchKernelGGL(hybrid_fwd, dim3(grid), dim3(NWAVES * 64), LDS_BYTES, stream, a); }
#endif
}
```

```cpp
#include <hip/hip_runtime.h>
#include <cstdio>
#include <cstdint>
namespace pg8 {
#define PG8_LAS __attribute__((address_space(3)))
typedef unsigned short bf16_t;
typedef short bf16x8 __attribute__((ext_vector_type(8)));
typedef float f32x4 __attribute__((ext_vector_type(4)));
typedef unsigned u32x4 __attribute__((ext_vector_type(4)));
constexpr int BM = 256, BK = 64, HALF = 128, HTB = HALF * BK * 2  , STAGE_BYTES = 8 * HTB, NXCD = 8, WGM = 8;

__host__ __device__ __forceinline__ int lds_byte(int r, int c) { const int st = (r >> 4) * 2 + (c >> 5), rr = r & 15, cc = c & 31, ob = rr * 64 + cc * 2; return st * 1024 + (ob ^ (((ob >> 9) & 1) << 5)); }
__host__ __device__ __forceinline__ void stage_rc(int b, int& R, int& C) { const int st = b / 1024, sb = b % 1024, swz = sb ^ (((sb >> 9) & 1) << 5); R = (st >> 1) * 16 + swz / 64; C = (st & 1) * 32 + (swz % 64) / 2; }
__host__ __device__ __forceinline__ int perm32(int rho) { const int n = rho >> 4, i = rho & 15; return 8 * (i >> 2) + 4 * n + (i & 3); }

struct Unit { int pm, pn, kb; };
struct Gemm { const bf16_t* A; const bf16_t* Bt; int M, N, K, ld; };

struct StaticOrder {
    int nM, nN, nwg, G, c;
    __host__ __device__ void init(int M, int N, int G_, int c_) { nM = M / BM; nN = N / BM; nwg = nM * nN; G = G_; c = c_; }
    __host__ __device__ bool next(int i, Unit& u) const {
        const long L = (long)i * G + c; if (L >= nwg) return false;
        int wgid = (int)L; { const int q = nwg / NXCD, r = nwg % NXCD, xcd = wgid % NXCD, off = wgid / NXCD; wgid = (xcd < r ? xcd * (q + 1) : r * (q + 1) + (xcd - r) * q) + off; }
        const int nig = WGM * nN, gid = wgid / nig, fm = gid * WGM, gsz = (nM - fm) < WGM ? (nM - fm) : WGM;
        u.pm = fm + ((wgid % nig) % gsz); u.pn = (wgid % nig) / gsz; u.kb = 0; return true;
    }
    __device__ __forceinline__ void a_ready(const Unit&) const {}
    __device__ __forceinline__ void done(const Unit&) const {}
};
template <class Epi, class Sched, bool ALIGN_EPI = false, bool SP2 = false>
__device__ __forceinline__ void gemm_phase(PG8_LAS unsigned char* lds, const Gemm g, const Sched& S, const Epi& E) {
    int tid_ = threadIdx.x; asm volatile("" : "+v"(tid_));
    const int tid = tid_, wid = __builtin_amdgcn_readfirstlane(tid >> 6), lane = tid & 63, wr = wid >> 2, wc = wid & 3, fr = lane & 15, fq = lane >> 4;
    const int K = g.K, nt = K / BK, LD = g.ld ? g.ld : g.K;
    unsigned voffA[2], voffB[2];
#pragma unroll
    for (int i = 0; i < 2; ++i) { int R, C; stage_rc(tid * 16 + i * 8192, R, C); const int Rb = Epi::PERM ? ((R & ~31) + perm32(R & 31)) : R;
        voffA[i] = (unsigned)(R * LD + C) * 2u; voffB[i] = (unsigned)(Rb * LD + C) * 2u; }
    const size_t kstep = (size_t)(BK * 2);
    const size_t hstep = (size_t)HALF * LD * 2;
    const size_t tstep = 2 * hstep;
    const unsigned ldsw = (unsigned)wid * 1024u;
    const int aoff = lds_byte(wr * 64 + fr, fq * 8), boff = lds_byte(wc * 32 + fr, fq * 8);
#define PG8_SA(b, h) (((b) * 2 + (h)) * HTB)
#define PG8_SB(b, h) ((4 + (b) * 2 + (h)) * HTB)
#define PG8_STAGE(bufoff, gbase, voff) do { _Pragma("unroll") for (int _i = 0; _i < 2; ++_i) \
        __builtin_amdgcn_global_load_lds((const unsigned*)((const char*)(gbase) + (voff)[_i]), (PG8_LAS unsigned*)(lds + (bufoff) + ldsw + _i * 8192), 16, 0, 0); } while (0)
#define PG8_LDA(dst, b, h) do { _Pragma("unroll") for (int m = 0; m < 4; ++m) _Pragma("unroll") for (int k = 0; k < 2; ++k) dst[m][k] = *(const PG8_LAS bf16x8*)(lds + PG8_SA(b, h) + aoff + m * 2048 + k * 1024); } while (0)
#define PG8_LDB(dst, b, h) do { _Pragma("unroll") for (int n = 0; n < 2; ++n) _Pragma("unroll") for (int k = 0; k < 2; ++k) dst[n][k] = *(const PG8_LAS bf16x8*)(lds + PG8_SB(b, h) + boff + n * 2048 + k * 1024); } while (0)
#define PG8_MMA(ai, bj, At, Bt) do { __builtin_amdgcn_s_setprio(1); _Pragma("unroll") for (int m = 0; m < 4; ++m) _Pragma("unroll") for (int n = 0; n < 2; ++n) _Pragma("unroll") for (int k = 0; k < 2; ++k) \
        acc[ai][bj][m][n] = __builtin_amdgcn_mfma_f32_16x16x32_bf16(Bt[n][k], At[m][k], acc[ai][bj][m][n], 0, 0, 0); __builtin_amdgcn_s_setprio(0); } while (0)
#define PG8_WAIT_V(n) asm volatile("s_waitcnt vmcnt(" #n ")" ::: "memory")
#define PG8_WAIT_L(n) asm volatile("s_waitcnt lgkmcnt(" #n ")" ::: "memory")
#define PG8_BAR __builtin_amdgcn_s_barrier()
#define PG8_SCHED __builtin_amdgcn_sched_barrier(0)
    Unit cur, nxt; int ui = 0;
    if (!S.next(0, cur)) return;
    f32x4 acc[2][2][4][2];
#pragma unroll
    for (int a = 0; a < 2; ++a)
#pragma unroll
        for (int b = 0; b < 2; ++b)
#pragma unroll
            for (int m = 0; m < 4; ++m)
#pragma unroll
                for (int n = 0; n < 2; ++n) acc[a][b][m][n] = (f32x4){0.f, 0.f, 0.f, 0.f};
    bf16x8 At[4][2], B0[2][2], B1[2][2];
    const char* cA = (const char*)g.A + (size_t)cur.pm * tstep + cur.kb; const char* cB = (const char*)g.Bt + (size_t)cur.pn * tstep + cur.kb;
    S.a_ready(cur);
    if constexpr (SP2) {
        PG8_STAGE(PG8_SB(0, 0), cB, voffB); PG8_STAGE(PG8_SB(0, 1), cB + hstep, voffB); PG8_STAGE(PG8_SA(0, 0), cA, voffA); PG8_STAGE(PG8_SA(0, 1), cA + hstep, voffA);
        if (wr == 1) PG8_BAR;
        PG8_WAIT_V(2); PG8_BAR;
        PG8_STAGE(PG8_SB(1, 0), cB + kstep, voffB); PG8_STAGE(PG8_SA(1, 0), cA + kstep, voffA); PG8_STAGE(PG8_SB(1, 1), cB + hstep + kstep, voffB);
        PG8_WAIT_V(6); PG8_BAR;
    } else {
        PG8_STAGE(PG8_SB(0, 0), cB, voffB); PG8_STAGE(PG8_SA(0, 0), cA, voffA); PG8_STAGE(PG8_SB(0, 1), cB + hstep, voffB); PG8_STAGE(PG8_SA(0, 1), cA + hstep, voffA);
        if (wr == 1) PG8_BAR;
        PG8_WAIT_V(4); PG8_BAR;
        PG8_STAGE(PG8_SB(1, 0), cB + kstep, voffB); PG8_STAGE(PG8_SA(1, 0), cA + kstep, voffA); PG8_STAGE(PG8_SB(1, 1), cB + hstep + kstep, voffB);
        PG8_WAIT_V(6); PG8_BAR;
    }
    for (;;) {
        const bool has_next = S.next(ui + 1, nxt);
        const char* nA = has_next ? (const char*)g.A + (size_t)nxt.pm * tstep + nxt.kb : cA; const char* nB = has_next ? (const char*)g.Bt + (size_t)nxt.pn * tstep + nxt.kb : cB;
        asm volatile(".p2align 6");
        for (int t = 0; t < nt; t += 2) {
            const bool last = (t == nt - 2);
            const char* a1 = cA + (size_t)(t + 1) * kstep;
            const char* a2 = last ? nA : cA + (size_t)(t + 2) * kstep; const char* b2 = last ? nB : cB + (size_t)(t + 2) * kstep;
            const char* a3 = a2 + kstep; const char* b3 = b2 + kstep;
            if (last && has_next) S.a_ready(nxt);
            if constexpr (SP2) {
            PG8_LDB(B0, 0, 0); PG8_LDB(B1, 0, 1); PG8_SCHED; PG8_LDA(At, 0, 0); PG8_STAGE(PG8_SA(1, 1), a1 + hstep, voffA);
            PG8_WAIT_V(8); PG8_WAIT_L(0); PG8_BAR; PG8_MMA(0, 0, At, B0); PG8_MMA(0, 1, At, B1); PG8_BAR; PG8_SCHED;
            PG8_LDA(At, 0, 1); PG8_STAGE(PG8_SB(0, 0), b2, voffB); PG8_STAGE(PG8_SB(0, 1), b2 + hstep, voffB); PG8_STAGE(PG8_SA(0, 0), a2, voffA);
            PG8_WAIT_V(8); PG8_WAIT_L(0); PG8_BAR; PG8_MMA(1, 0, At, B0); PG8_MMA(1, 1, At, B1); PG8_BAR; PG8_SCHED;
            PG8_LDB(B0, 1, 0); PG8_LDB(B1, 1, 1); PG8_SCHED; PG8_LDA(At, 1, 0); PG8_STAGE(PG8_SA(0, 1), a2 + hstep, voffA);
            PG8_WAIT_V(8); PG8_WAIT_L(0); PG8_BAR; PG8_MMA(0, 0, At, B0); PG8_MMA(0, 1, At, B1); PG8_BAR; PG8_SCHED;
            PG8_LDA(At, 1, 1); PG8_STAGE(PG8_SB(1, 0), b3, voffB); PG8_STAGE(PG8_SB(1, 1), b3 + hstep, voffB); PG8_STAGE(PG8_SA(1, 0), a3, voffA);
            PG8_WAIT_V(8); PG8_WAIT_L(0); PG8_BAR; PG8_MMA(1, 0, At, B0); PG8_MMA(1, 1, At, B1); PG8_BAR; PG8_SCHED;
            } else {
            PG8_LDB(B0, 0, 0); PG8_SCHED; PG8_LDA(At, 0, 0); PG8_STAGE(PG8_SA(1, 1), a1 + hstep, voffA);
            PG8_WAIT_L(8); PG8_BAR; PG8_WAIT_L(0); PG8_MMA(0, 0, At, B0); PG8_BAR; PG8_SCHED;
            PG8_LDB(B1, 0, 1); PG8_STAGE(PG8_SB(0, 0), b2, voffB);
            PG8_BAR; PG8_WAIT_L(0); PG8_MMA(0, 1, At, B1); PG8_BAR;
            PG8_LDA(At, 0, 1); PG8_STAGE(PG8_SA(0, 0), a2, voffA);
            PG8_BAR; PG8_WAIT_L(0); PG8_MMA(1, 0, At, B0); PG8_BAR; PG8_SCHED;
            PG8_STAGE(PG8_SB(0, 1), b2 + hstep, voffB);
            PG8_WAIT_V(6); PG8_BAR; PG8_MMA(1, 1, At, B1); PG8_BAR;
            PG8_LDB(B0, 1, 0); PG8_SCHED; PG8_LDA(At, 1, 0); PG8_STAGE(PG8_SA(0, 1), a2 + hstep, voffA);
            PG8_WAIT_L(8); PG8_BAR; PG8_WAIT_L(0); PG8_MMA(0, 0, At, B0); PG8_BAR; PG8_SCHED;
            PG8_LDB(B1, 1, 1); PG8_STAGE(PG8_SB(1, 0), b3, voffB);
            PG8_BAR; PG8_WAIT_L(0); PG8_MMA(0, 1, At, B1); PG8_BAR;
            PG8_LDA(At, 1, 1); PG8_STAGE(PG8_SA(1, 0), a3, voffA);
            PG8_BAR; PG8_WAIT_L(0); PG8_MMA(1, 0, At, B0); PG8_BAR; PG8_SCHED;
            PG8_STAGE(PG8_SB(1, 1), b3 + hstep, voffB);
            PG8_WAIT_V(6); PG8_BAR; PG8_MMA(1, 1, At, B1); PG8_BAR;
            }
        }
        if constexpr (ALIGN_EPI) { if (wr == 0) PG8_BAR; }
        if constexpr (!Epi::AFTER_DRAIN) { E(acc, cur, wr, wc, fr, fq); S.done(cur); }
        if (!has_next) break;
#pragma unroll
        for (int a = 0; a < 2; ++a)
#pragma unroll
            for (int b = 0; b < 2; ++b)
#pragma unroll
                for (int m = 0; m < 4; ++m)
#pragma unroll
                    for (int n = 0; n < 2; ++n) acc[a][b][m][n] = (f32x4){0.f, 0.f, 0.f, 0.f};
        cur = nxt; cA = nA; cB = nB; ++ui;
        if constexpr (ALIGN_EPI) { if (wr == 1) PG8_BAR; }
    }
    PG8_WAIT_V(0);
    if constexpr (!ALIGN_EPI) { if (wr == 0) PG8_BAR; }
    PG8_BAR;
    if constexpr (Epi::AFTER_DRAIN) { E.fused(acc, cur, wr, wc, fr, fq, lds, wid, lane); S.done(cur); }
#undef PG8_SA
#undef PG8_SB
#undef PG8_STAGE
#undef PG8_LDA
#undef PG8_LDB
#undef PG8_MMA
#undef PG8_WAIT_V
#undef PG8_WAIT_L
#undef PG8_BAR
#undef PG8_SCHED
}
}

constexpr int DM = 2048, NB = 8, TT = 2048, NDB = 128, NTS = 8, DFF = 5632;
constexpr int MP = NB * TT, MS = NDB * NTS, MTOT = MP + MS;
constexpr int NSEQ = NDB + NB;
constexpr int NIN = 5632, NEXTRA = 64;
constexpr int GLAW = 3072;
constexpr int XROWS = NSEQ * 4 * 128;
constexpr float LN_EPS = 1e-5f, ALPHA = 1.189207115002721f, LOG2E = 1.4426950408889634f;
constexpr int NWAVES = 8;

constexpr size_t O_YP = 0, O_YS = 33554432, O_CMPP = 35651584, O_SLCP = 44040192, O_WINP = 52428800, O_GLAP = 54525952,
                 O_CMPS = 55574528, O_SLCS = 56098816, O_WINS = 56623104, O_GLAS = 90177536, O_END = 106954752;

constexpr size_t MiB = 1u << 20;
constexpr size_t WS_CTL = 0, CTL_ZERO_BYTES = 64 * 1024;
constexpr size_t WS_SMALL = 1 * MiB;
constexpr size_t WS_W1A = 2 * MiB;
constexpr size_t WS_W1B = WS_W1A + 44 * MiB;
constexpr size_t WS_WIN = WS_W1B + 22 * MiB;
constexpr size_t WS_WOUT = WS_WIN + 23 * MiB;
constexpr size_t WS_W2A = WS_WOUT + 8 * MiB;
constexpr size_t WS_W2B = WS_W2A + 44 * MiB;
constexpr size_t WS_CW1 = WS_W2B + 22 * MiB;
constexpr size_t WS_XB = WS_CW1 + 1 * MiB;
constexpr size_t WS_HB = WS_XB + 68 * MiB;
constexpr size_t WS_ZF = WS_HB + 187 * MiB;
constexpr size_t WS_GLAIN = WS_ZF + 136 * MiB;
constexpr size_t WS_NQ = WS_GLAIN + 204 * MiB;
constexpr size_t WS_EXTRA = WS_NQ + 34 * MiB;
constexpr size_t WS_WINROWS = WS_EXTRA + 5 * MiB;
constexpr size_t WS_ORAW = WS_WINROWS + 32 * MiB;
constexpr size_t WS_MIX = WS_ORAW + 64 * MiB;
constexpr size_t WS_XBLK = WS_MIX + 68 * MiB;
constexpr size_t WS_ZC = WS_XBLK + 272 * MiB;
constexpr size_t WS_KCMP = WS_ZC + 136 * MiB;
constexpr size_t WS_GQ = WS_KCMP + 34 * MiB;
constexpr size_t WS_GKT = WS_GQ + 16 * MiB;
constexpr size_t WS_GA = WS_GKT + 16 * MiB;
constexpr size_t WS_GVT = WS_GA + 8 * MiB;
constexpr size_t WS_GD = WS_GVT + 32 * MiB;
constexpr size_t WS_SLAB = WS_GD + 1 * MiB;
constexpr size_t WS_KB16 = WS_SLAB + 32 * MiB;
constexpr size_t WS_VT16 = WS_KB16 + 16 * MiB;
constexpr size_t WS_KC16 = WS_VT16 + 16 * MiB;
constexpr size_t WS_VCT16 = WS_KC16 + 9 * MiB;
constexpr size_t WS_END = WS_VCT16 + 9 * MiB;
constexpr int CW_TMO = 0, CW_CODE = 1, CW_BAR = 4096;

constexpr int RING_BYTES = 131072;
constexpr int LDSCTL_OFF = RING_BYTES, MISC_OFF = LDSCTL_OFF + 320;
constexpr int LDS_BYTES = 147456;

#define GAS __attribute__((address_space(1)))
#define LAS __attribute__((address_space(3)))
typedef unsigned short bf16;
typedef float f32x2 __attribute__((ext_vector_type(2)));
typedef float f32x4 __attribute__((ext_vector_type(4)));
typedef float f32x16 __attribute__((ext_vector_type(16)));
typedef short bf16x8 __attribute__((ext_vector_type(8)));
typedef short s16x4 __attribute__((ext_vector_type(4)));
typedef unsigned u32x2 __attribute__((ext_vector_type(2)));
typedef unsigned u32x4 __attribute__((ext_vector_type(4)));
typedef __bf16 bf16x2_t __attribute__((ext_vector_type(2)));
typedef GAS unsigned gu32;
#define RLX_AGENT __ATOMIC_RELAXED, __HIP_MEMORY_SCOPE_AGENT
#define LDS_WAIT() asm volatile("s_waitcnt lgkmcnt(0)" ::: "memory")
#define VM_WAIT() asm volatile("s_waitcnt vmcnt(0)" ::: "memory")
#define DI __device__ __forceinline__

DI unsigned pk2(float lo, float hi) { f32x2 v = {lo, hi}; bf16x2_t b = __builtin_convertvector(v, bf16x2_t); return __builtin_bit_cast(unsigned, b); }
DI float wave_sum(float v) {
#pragma unroll
    for (int o = 1; o < 64; o <<= 1) v += __shfl_xor(v, o);
    return v;
}
DI float fexp2(float x) { return __builtin_amdgcn_exp2f(x); }
DI float frcp(float x) { return __builtin_amdgcn_rcpf(x); }
DI float sigmoidf_(float x) { return frcp(1.f + fexp2(-x * LOG2E)); }
DI float siluf_(float x) { return x * sigmoidf_(x); }


struct EpiSwiGLU {
    static constexpr bool PERM = true, AFTER_DRAIN = false;
    bf16* H;
    DI void operator()(const f32x4 (&acc)[2][2][4][2], const pg8::Unit& u, int wr, int wc, int fr, int fq) const {
        const int row0 = u.pm * 256 + wr * 64 + fr, col0 = u.pn * 128 + wc * 32 + 8 * fq;
#pragma unroll
        for (int ai = 0; ai < 2; ++ai)
#pragma unroll
            for (int m = 0; m < 4; ++m) {
                const f32x4 g0 = acc[ai][0][m][0], g1 = acc[ai][0][m][1], u0 = acc[ai][1][m][0], u1 = acc[ai][1][m][1];
                u32x4 w;
                w.x = pk2(siluf_(g0[0]) * u0[0], siluf_(g0[1]) * u0[1]); w.y = pk2(siluf_(g0[2]) * u0[2], siluf_(g0[3]) * u0[3]);
                w.z = pk2(siluf_(g1[0]) * u1[0], siluf_(g1[1]) * u1[1]); w.w = pk2(siluf_(g1[2]) * u1[2], siluf_(g1[3]) * u1[3]);
                *(u32x4*)(H + (size_t)(row0 + ai * 128 + m * 16) * DFF + col0) = w;
            }
    }
};

DI f32x4 bf4_lo(u32x4 q) { return (f32x4){__builtin_bit_cast(float, q.x << 16), __builtin_bit_cast(float, q.x & 0xffff0000u), __builtin_bit_cast(float, q.y << 16), __builtin_bit_cast(float, q.y & 0xffff0000u)}; }
DI f32x4 bf4_hi(u32x4 q) { return (f32x4){__builtin_bit_cast(float, q.z << 16), __builtin_bit_cast(float, q.z & 0xffff0000u), __builtin_bit_cast(float, q.w << 16), __builtin_bit_cast(float, q.w & 0xffff0000u)}; }
struct EpiResid {
    static constexpr bool PERM = true, AFTER_DRAIN = false;
    const float* res; bf16* out; float sc;
    DI void operator()(const f32x4 (&acc)[2][2][4][2], const pg8::Unit& u, int wr, int wc, int fr, int fq) const {
        const int row0 = u.pm * 256 + wr * 64 + fr, col0 = u.pn * 256 + wc * 32 + 8 * fq;
#pragma unroll
        for (int ai = 0; ai < 2; ++ai) {
            f32x4 r[4][2][2];
#pragma unroll
            for (int m = 0; m < 4; ++m)
#pragma unroll
                for (int bj = 0; bj < 2; ++bj)
#pragma unroll
                    for (int n = 0; n < 2; ++n) r[m][bj][n] = __builtin_nontemporal_load((const f32x4*)(res + (size_t)(row0 + ai * 128 + m * 16) * DM + col0 + bj * 128 + n * 4));
            asm volatile("" ::: "memory");
#pragma unroll
            for (int m = 0; m < 4; ++m)
#pragma unroll
                for (int bj = 0; bj < 2; ++bj) { const f32x4 a = r[m][bj][0] * ALPHA + acc[ai][bj][m][0] * sc, b = r[m][bj][1] * ALPHA + acc[ai][bj][m][1] * sc;
                    *(u32x4*)(out + (size_t)(row0 + ai * 128 + m * 16) * DM + col0 + bj * 128) = (u32x4){pk2(a[0], a[1]), pk2(a[2], a[3]), pk2(b[0], b[1]), pk2(b[2], b[3])}; }
        }
    }
};
struct EpiResid16 {
    static constexpr bool PERM = true, AFTER_DRAIN = false;
    const bf16* res; bf16* out; float sc;
    DI void operator()(const f32x4 (&acc)[2][2][4][2], const pg8::Unit& u, int wr, int wc, int fr, int fq) const {
        const int row0 = u.pm * 256 + wr * 64 + fr, col0 = u.pn * 256 + wc * 32 + 8 * fq;
#pragma unroll
        for (int ai = 0; ai < 2; ++ai) {
            u32x4 r[4][2];
#pragma unroll
            for (int m = 0; m < 4; ++m)
#pragma unroll
                for (int bj = 0; bj < 2; ++bj) r[m][bj] = *(const u32x4*)(res + (size_t)(row0 + ai * 128 + m * 16) * DM + col0 + bj * 128);
            asm volatile("" ::: "memory");
#pragma unroll
            for (int m = 0; m < 4; ++m)
#pragma unroll
                for (int bj = 0; bj < 2; ++bj) { const f32x4 a = bf4_lo(r[m][bj]) * ALPHA + acc[ai][bj][m][0] * sc, b = bf4_hi(r[m][bj]) * ALPHA + acc[ai][bj][m][1] * sc;
                    *(u32x4*)(out + (size_t)(row0 + ai * 128 + m * 16) * DM + col0 + bj * 128) = (u32x4){pk2(a[0], a[1]), pk2(a[2], a[3]), pk2(b[0], b[1]), pk2(b[2], b[3])}; }
        }
    }
};

struct EpiZ {
    static constexpr bool PERM = true, AFTER_DRAIN = false;
    bf16* Z;
    DI void operator()(const f32x4 (&acc)[2][2][4][2], const pg8::Unit& u, int wr, int wc, int fr, int fq) const {
        const int row0 = u.pm * 256 + wr * 64 + fr, col0 = wc * 32 + 8 * fq;
#pragma unroll
        for (int ai = 0; ai < 2; ++ai)
#pragma unroll
            for (int m = 0; m < 4; ++m) {
                const size_t off = (size_t)(row0 + ai * 128 + m * 16) * 256 + col0;
#pragma unroll
                for (int bj = 0; bj < 2; ++bj) { const f32x4 a = acc[ai][bj][m][0], b = acc[ai][bj][m][1];
                    *(u32x4*)(Z + off + bj * 128) = (u32x4){pk2(a[0], a[1]), pk2(a[2], a[3]), pk2(b[0], b[1]), pk2(b[2], b[3])}; }
            }
    }
};
struct CmpOrder {
    int G, c;
    DI bool next(int i, pg8::Unit& u) const { const int L = i * G + c; if (L >= 2 * (XROWS / 256)) return false; u.pm = L; u.pn = L / (XROWS / 256); u.kb = 0; return true; }
    DI void a_ready(const pg8::Unit&) const {}
    DI void done(const pg8::Unit&) const {}
};

constexpr int NSPLIT = 4;
struct SplitOrder {
    int G, c, kslice_bytes;
    DI bool next(int i, pg8::Unit& u) const { const int L = i * G + c; if (L >= 32 * NSPLIT) return false; const int t = L / NSPLIT, ks = L % NSPLIT; u.pm = MP / 256 + (t >> 3); u.pn = t & 7; u.kb = ks * kslice_bytes; return true; }
    DI void a_ready(const pg8::Unit&) const {}
    DI void done(const pg8::Unit&) const {}
};
struct EpiSlab {
    static constexpr bool PERM = false, AFTER_DRAIN = false;
    float* slab; int kslice_bytes;
    DI void operator()(const f32x4 (&acc)[2][2][4][2], const pg8::Unit& u, int wr, int wc, int fr, int fq) const {
        const int row0 = (u.pm - MP / 256) * 256 + wr * 64 + fr, col0 = u.pn * 256 + wc * 32 + 4 * fq;
        float* dst = slab + (size_t)(u.kb / kslice_bytes) * MS * DM;
#pragma unroll
        for (int ai = 0; ai < 2; ++ai)
#pragma unroll
            for (int m = 0; m < 4; ++m) {
                const size_t off = (size_t)(row0 + ai * 128 + m * 16) * DM + col0;
#pragma unroll
                for (int bj = 0; bj < 2; ++bj)
#pragma unroll
                    for (int n = 0; n < 2; ++n) *(f32x4*)(dst + off + bj * 128 + n * 16) = acc[ai][bj][m][n];
            }
    }
};

struct EpiInProj {
    static constexpr bool PERM = false, AFTER_DRAIN = false;
    bf16* glain; bf16* nq; float* out; float* winrows; bf16* xblk; bf16* kb16; bf16* vt16;
    DI void operator()(const f32x4 (&acc)[2][2][4][2], const pg8::Unit& u, int wr, int wc, int fr, int fq) const {
        const int row0 = u.pm * 256 + wr * 64 + fr, pn = u.pn;
        if (pn < 12) {
            const float sc = pn < 2 ? 0.08838834764831845f : 1.f;
            const int col0 = pn * 256 + wc * 32 + 4 * fq;
#pragma unroll
            for (int ai = 0; ai < 2; ++ai)
#pragma unroll
                for (int m = 0; m < 4; ++m) {
                    const size_t off = (size_t)(row0 + ai * 128 + m * 16) * GLAW + col0;
#pragma unroll
                    for (int bj = 0; bj < 2; ++bj)
#pragma unroll
                        for (int n = 0; n < 2; ++n) { const f32x4 a = acc[ai][bj][m][n] * sc; *(u32x2*)(glain + off + bj * 128 + n * 16) = (u32x2){pk2(a[0], a[1]), pk2(a[2], a[3])}; }
                }
            return;
        }
        const int dlo = 16 * (wc & 1) + 4 * fq;
        float frev[4];
#pragma unroll
        for (int i = 0; i < 4; ++i) frev[i] = fexp2(-(float)(dlo + i) * (13.287712379549449f / 32.f)) * 0.15915494309189535f;
        const int which = pn - 16;
        const bool dorope = (pn < 16) || ((which & 1) == 0);
#pragma unroll
        for (int ai = 0; ai < 2; ++ai)
#pragma unroll
            for (int m = 0; m < 4; ++m) {
                const int row = row0 + ai * 128 + m * 16;
                const bool samp = row >= MP;
                const int srow = row - MP;
                const int pos = samp ? (TT + (srow & 7)) : (row & (TT - 1));
                float cs[4], sn[4];
#pragma unroll
                for (int i = 0; i < 4; ++i) { float rev = (float)pos * frev[i]; rev = rev - floorf(rev); cs[i] = __builtin_amdgcn_cosf(rev); sn[i] = __builtin_amdgcn_sinf(rev); }
#pragma unroll
                for (int bj = 0; bj < 2; ++bj) {
                    f32x4 x1 = acc[ai][bj][m][0], x2 = acc[ai][bj][m][1], o1, o2;
                    if (dorope) {
#pragma unroll
                        for (int i = 0; i < 4; ++i) { o1[i] = x1[i] * cs[i] - x2[i] * sn[i]; o2[i] = x2[i] * cs[i] + x1[i] * sn[i]; }
                    } else { o1 = x1; o2 = x2; }
                    const int hh = 2 * bj + (wc >> 1);
                    if (pn < 16) {
                        const int head = (pn - 12) * 4 + hh;
                        bf16* q = nq + (size_t)row * 1024 + head * 64 + dlo;
                        u32x2 w1, w2; w1.x = pk2(o1[0] * 0.125f, o1[1] * 0.125f); w1.y = pk2(o1[2] * 0.125f, o1[3] * 0.125f); w2.x = pk2(o2[0] * 0.125f, o2[1] * 0.125f); w2.y = pk2(o2[2] * 0.125f, o2[3] * 0.125f);
                        *(u32x2*)q = w1; *(u32x2*)(q + 32) = w2;
                    } else {
                        const int br = which >> 1, kvsel = which & 1;
                        const int inrow = kvsel * 256 + hh * 64 + dlo;
                        float* dst;
                        if (br == 0) dst = out + (samp ? O_CMPS + (size_t)srow * 512 : O_CMPP + (size_t)row * 512);
                        else if (br == 1) dst = out + (samp ? O_SLCS + (size_t)srow * 512 : O_SLCP + (size_t)row * 512);
                        else dst = samp ? out + O_WINS + ((size_t)(srow >> 3) * 512 + 504 + (srow & 7)) * 512 : winrows + (size_t)row * 512;
                        *(f32x4*)(dst + inrow) = o1; *(f32x4*)(dst + inrow + 32) = o2;
                        if (br == 2 && !samp && (row & (TT - 1)) >= TT - 512) {
                            float* d2 = out + O_WINP + ((size_t)(row >> 11) * 512 + (row & (TT - 1)) - (TT - 512)) * 512 + inrow;
                            *(f32x4*)d2 = o1; *(f32x4*)(d2 + 32) = o2;
                        }
                        if (br != 0 && !samp) {
                            const int b = row >> 11, t = row & (TT - 1);
                            bf16* kp = (kvsel == 0 ? kb16 : vt16) + (((size_t)(br - 1) * NB * 4 + b * 4 + hh) * TT + t) * 64 + dlo;
                            u32x2 w1, w2; w1.x = pk2(o1[0], o1[1]); w1.y = pk2(o1[2], o1[3]); w2.x = pk2(o2[0], o2[1]); w2.y = pk2(o2[2], o2[3]);
                            *(u32x2*)kp = w1; *(u32x2*)(kp + 32) = w2;
                        }
                        if (br == 0 && !samp) {
                            const int b = row >> 11, t = row & (TT - 1);
                            bf16* xb = xblk + ((size_t)kvsel * XROWS + (size_t)((NDB + b) * 4 + hh) * 128 + (t >> 4)) * 1024 + (t & 15) * 64 + dlo;
                            u32x2 w1, w2; w1.x = pk2(o1[0], o1[1]); w1.y = pk2(o1[2], o1[3]); w2.x = pk2(o2[0], o2[1]); w2.y = pk2(o2[2], o2[3]);
                            *(u32x2*)xb = w1; *(u32x2*)(xb + 32) = w2;
                        }
                    }
                }
            }
    }
};
#define XB_TMO      128
#define XB_XCNT(j)  (256  + 64 * (j))
#define XB_XSUB(j)  (1280 + 64 * (j))
#define XB_XGEN(j)  (2304 + 64 * (j))
#define XB_TOP      3328
#define XB_TOPGEN   3392
#define XCD_BAR_WORDS 3456
#define XB_SPIN_CAP (1u << 18)

__device__ __forceinline__ unsigned xb_ld(unsigned* p)              { return __hip_atomic_load(p, __ATOMIC_RELAXED, __HIP_MEMORY_SCOPE_AGENT); }
__device__ __forceinline__ unsigned xb_add(unsigned* p, unsigned v) { return __hip_atomic_fetch_add(p, v, __ATOMIC_RELAXED, __HIP_MEMORY_SCOPE_AGENT); }
__device__ __forceinline__ unsigned xb_xcc_id() { return (unsigned)__builtin_amdgcn_s_getreg((3 << 11) | 20) & 0xFu; }
#define XB_SPIN(cond, bar) do { unsigned _sp = 0; while (cond) { __builtin_amdgcn_s_sleep(1); \
    if ((++_sp & 255u) == 0u) { if (xb_ld(&(bar)[XB_TMO])) break; if (_sp > XB_SPIN_CAP) { atomicAdd(&(bar)[XB_TMO], 1u); break; } } } } while (0)

struct XcdBarrier {
    unsigned* bar; unsigned x;
    volatile LAS unsigned* st;
};

__device__ __forceinline__ XcdBarrier xcd_barrier_post(unsigned* bar, volatile LAS unsigned* st) {
    XcdBarrier b; b.bar = bar; b.x = xb_xcc_id(); b.st = st;
    if (threadIdx.x == 0) (void)xb_add(&bar[XB_XCNT(b.x)], 1u);
    return b;
}
__device__ __forceinline__ void xcd_barrier_complete(unsigned* bar, unsigned x, unsigned& nloc, unsigned& nx) {
    const unsigned G = gridDim.x * gridDim.y * gridDim.z;
    unsigned sum, cnt, mine, sp = 0u;
    for (;;) {
        sum = 0u; cnt = 0u; mine = 0u;
#pragma unroll
        for (unsigned j = 0; j < 16; ++j) { const unsigned c = xb_ld(&bar[XB_XCNT(j)]); sum += c; cnt += (c > 0u) ? 1u : 0u; mine = (j == x) ? c : mine; }
        if (sum == G) break;
        __builtin_amdgcn_s_sleep(1);
        if ((++sp & 255u) == 0u) { if (xb_ld(&bar[XB_TMO])) break; if (sp > XB_SPIN_CAP) { atomicAdd(&bar[XB_TMO], 1u); break; } }
    }
    nloc = mine > 0u ? mine : 1u; nx = cnt > 0u ? cnt : 1u;
}

__device__ __forceinline__ void xcd_barrier(const XcdBarrier& b) {
    asm volatile("s_waitcnt vmcnt(0)" ::: "memory");
    __syncthreads();
    if (threadIdx.x == 0) {
        unsigned* bar = b.bar;
        __builtin_amdgcn_s_waitcnt(0);
        unsigned nloc = b.st[0], nx = b.st[1];
        if (nloc == 0u) { xcd_barrier_complete(bar, b.x, nloc, nx); b.st[0] = nloc; b.st[1] = nx; }
        const unsigned old = xb_add(&bar[XB_XSUB(b.x)], 1u);
        const unsigned gen = old / nloc;
        if (old + 1u == (gen + 1u) * nloc) {
            __builtin_amdgcn_fence(__ATOMIC_RELEASE, "agent");
            asm volatile("s_waitcnt vmcnt(0)" ::: "memory");
            const unsigned og = xb_add(&bar[XB_TOP], 1u);
            const unsigned tg = og / nx;
            if (og + 1u == (tg + 1u) * nx) xb_add(&bar[XB_TOPGEN], 1u);
            else XB_SPIN(xb_ld(&bar[XB_TOPGEN]) == tg, bar);
            __builtin_amdgcn_fence(__ATOMIC_ACQUIRE, "agent");
            xb_add(&bar[XB_XGEN(b.x)], 1u);
            asm volatile("s_waitcnt vmcnt(0)" ::: "memory");
        } else {
            XB_SPIN(xb_ld(&bar[XB_XGEN(b.x)]) == gen, bar);
            __builtin_amdgcn_fence(__ATOMIC_ACQUIRE, "agent");
            asm volatile("s_waitcnt vmcnt(0)" ::: "memory");
        }
    }
    __syncthreads();
}

struct Frame {
    LAS unsigned char* lds;
    volatile LAS unsigned* MISC;
    gu32* ctl;
    int tid, lane, wave, vcu, G;
    const float *x_p, *x_s, *c_cmp, *c_slc, *c_win, *st_gla; const int* ptab;
    const float *w1a, *w1b, *w_in, *w_g2, *b_g2, *gnorm, *cpos, *cw1, *cw2, *w_out, *w2a, *w2b, *ln_g, *ln_b;
    float* out;
    bf16 *W1A, *W1B, *WIN, *WOUT, *W2A, *W2B, *CW1, *XB, *HB, *NQ, *MIX, *XBLK, *GQ, *GKT, *GA, *GVT, *KB16, *VT16, *KC16, *VCT16, *G16;
    float *CBIAS, *ZF, *EXTRA, *WINROWS, *ORAW, *ZC, *KCMP, *GD, *SLAB;
};

constexpr int W2A_S1 = 4500, W2A_S2 = 9000, WIN_DB1 = 20, WIN_DB2 = 84;
struct MapIdent { DI int operator()(int n) const { return n; } };
struct MapOff { int off; DI int operator()(int n) const { return off + n; } };
struct MapFfnIn { DI int operator()(int n) const { const int up = n >= DFF, c = up ? n - DFF : n; return (c >> 7) * 256 + up * 128 + (c & 127); } };
struct MapInProj {
    DI int operator()(int n) const {
        if (n < 2048) return n;
        if (n < 2064) return NIN + (n - 2048);
        if (n < 3088) return 2048 + (n - 2064);
        if (n < 5648) { const int c = n - 3088, d = c & 63, q = d >> 4; const int p = q == 1 ? d + 16 : (q == 2 ? d - 16 : d); return 3072 + (c - d) + p; }
        return n;
    }
};
template <class RowMap>
DI void transpose_item(const float* W, int ldw, int k0, int n0, bf16* WT, int ldt, int dcol0, const RowMap& rm, LAS float* scr, int lane) {
    f32x4 v[8];
#pragma unroll
    for (int i = 0; i < 8; ++i) v[i] = *(const f32x4*)(W + (size_t)(k0 + 8 * i + (lane >> 3)) * ldw + n0 + 4 * (lane & 7));
#pragma unroll
    for (int i = 0; i < 8; ++i) { LAS float* d = scr + (8 * i + (lane >> 3)) * 33 + 4 * (lane & 7); d[0] = v[i][0]; d[1] = v[i][1]; d[2] = v[i][2]; d[3] = v[i][3]; }
    LDS_WAIT(); asm volatile("" ::: "memory");
    const int c = lane & 7;
#pragma unroll
    for (int j = 0; j < 4; ++j) { const int n = (lane >> 3) + 8 * j; const LAS float* s = scr + (8 * c) * 33 + n;
        u32x4 o; o.x = pk2(s[0 * 33], s[1 * 33]); o.y = pk2(s[2 * 33], s[3 * 33]); o.z = pk2(s[4 * 33], s[5 * 33]); o.w = pk2(s[6 * 33], s[7 * 33]);
        *(u32x4*)(WT + (size_t)rm(n0 + n) * ldt + dcol0 + 8 * c) = o; }
    LDS_WAIT(); asm volatile("" ::: "memory");
}
template <class RowMap>
DI void transpose_matrix(const float* W, int K, int N, bf16* WT, const RowMap& rm, LAS float* scr, int gw, int NGW, int lane, int it0 = 0, int it1 = 0x7fffffff) {
    const int nblk = N / 32, nitems = (K / 64) * nblk < it1 ? (K / 64) * nblk : it1;
    for (int it = it0 + gw; it < nitems; it += NGW) { const int kb = it / nblk, nb = it % nblk; transpose_item(W, N, 64 * kb, 32 * nb, WT, K, 64 * kb, rm, scr, lane); }
}

DI void xblk_part(Frame& F, int rank, int nranks) {
    const int gw = rank * NWAVES + F.wave, NGW = nranks * NWAVES, lane = F.lane;
    for (int it0 = gw * 4; it0 < NDB * 2048; it0 += NGW * 4) {
        f32x4 v[4][2];
#pragma unroll
        for (int q = 0; q < 4; ++q) { const int it = it0 + q, s = it >> 11, row = it & 2047; const int page = F.ptab[s * 16 + (row >> 7)];
            const float* src = F.c_cmp + ((size_t)page * 128 + (row & 127)) * 512;
            v[q][0] = __builtin_nontemporal_load((const f32x4*)(src + 4 * lane)); v[q][1] = __builtin_nontemporal_load((const f32x4*)(src + 4 * (lane + 64))); }
#pragma unroll
        for (int q = 0; q < 4; ++q) { const int it = it0 + q, s = it >> 11, row = it & 2047;
#pragma unroll
            for (int j = 0; j < 2; ++j) { const int e = lane + 64 * j, kvsel = e >> 6, h = (e >> 4) & 3, d4 = (e & 15) * 4;
                u32x2 w; w.x = pk2(v[q][j][0], v[q][j][1]); w.y = pk2(v[q][j][2], v[q][j][3]);
                *(u32x2*)(F.XBLK + ((size_t)kvsel * XROWS + (size_t)(s * 4 + h) * 128 + (row >> 4)) * 1024 + (row & 15) * 64 + d4) = w; } }
    }
}
DI void p0_prologue(Frame& F) {
    LAS float* scr = (LAS float*)(F.lds + F.wave * 16384);
    const int gw = F.vcu * NWAVES + F.wave, NGW = F.G * NWAVES, lane = F.lane;
    transpose_matrix(F.w1a, DM, 2 * DFF, F.W1A, MapFfnIn{}, scr, gw, NGW, lane);
    for (int it = F.vcu + F.G * F.wave; it < 2 * 32 * 4; it += NGW) { const int kv = it >> 7, kb = (it >> 2) & 31, nb = it & 3;
        transpose_item(F.cw1 + (size_t)kv * 2048 * 128, 128, 64 * kb, 32 * nb, F.CW1 + (size_t)kv * 256 * 1024, 1024, (64 * kb) & 1023, MapOff{(kb >> 4) * 128}, scr, lane); }
    for (int it = F.vcu + F.G * ((F.wave + 4) & 7); it < 256; it += NGW) { const int kv = it >> 7, n = it & 127; float s = 0.f;
#pragma unroll
        for (int c = 0; c < 4; ++c) { float a[8], w[8];
#pragma unroll
            for (int i = 0; i < 8; ++i) { const int k = lane + 64 * (8 * c + i); a[i] = F.cpos[kv * 2048 + k]; w[i] = F.cw1[((size_t)kv * 2048 + k) * 128 + n]; }
#pragma unroll
            for (int i = 0; i < 8; ++i) s += a[i] * w[i]; }
        s = wave_sum(s); if (lane == 0) F.CBIAS[it] = s; }
    for (int m0 = 2 * gw; m0 < MTOT; m0 += 2 * NGW) {
        f32x4 v[2][8];
#pragma unroll
        for (int q = 0; q < 2; ++q) { const int m = m0 + q; const float* xr = m < MP ? F.x_p + (size_t)m * DM : F.x_s + (size_t)(m - MP) * DM;
#pragma unroll
            for (int j = 0; j < 8; ++j) v[q][j] = __builtin_nontemporal_load((const f32x4*)(xr + 4 * (lane + 64 * j))); }
#pragma unroll
        for (int q = 0; q < 2; ++q) { bf16* o = F.XB + (size_t)(m0 + q) * DM;
#pragma unroll
            for (int j = 0; j < 8; ++j) { u32x2 w; w.x = pk2(v[q][j][0], v[q][j][1]); w.y = pk2(v[q][j][2], v[q][j][3]); *(u32x2*)(o + 4 * (lane + 64 * j)) = w; } }
    }

}
DI void wincopy_part(Frame& F, int rank, int nranks, int db0, int db1) {
    const size_t per = (size_t)504 * 128, tot = (size_t)(db1 - db0) * per;
    const size_t step = (size_t)nranks * 512;
    for (size_t i0 = (size_t)rank * 512 + F.tid; i0 < tot; i0 += 8 * step) {
        f32x4 v[8];
#pragma unroll
        for (int u = 0; u < 8; ++u) { const size_t i = i0 + u * step; if (i < tot) { const size_t db = db0 + i / per, r = i % per; v[u] = __builtin_nontemporal_load((const f32x4*)F.c_win + db * (512 * 128) + 8 * 128 + r); } }
#pragma unroll
        for (int u = 0; u < 8; ++u) { const size_t i = i0 + u * step; if (i < tot) { const size_t db = db0 + i / per, r = i % per; __builtin_nontemporal_store(v[u], (f32x4*)(F.out + O_WINS) + db * (512 * 128) + r); } }
    }
}

DI void late_work(Frame& F, int part, int rank, int nranks) {
    LAS float* scr = (LAS float*)(F.lds + F.wave * 16384);
    const int gw = rank * NWAVES + F.wave, NGW = nranks * NWAVES, lane = F.lane;
    __syncthreads();
    if (part == 1) { transpose_matrix(F.w1b, DFF, DM, F.W1B, MapIdent{}, scr, gw, NGW, lane); transpose_matrix(F.w_out, DM, DM, F.WOUT, MapIdent{}, scr, gw, NGW, lane); }
    else if (part == 2) { transpose_matrix(F.w_in, DM, NIN + NEXTRA, F.WIN, MapInProj{}, scr, gw, NGW, lane); transpose_matrix(F.w2a, DM, 2 * DFF, F.W2A, MapFfnIn{}, scr, gw, NGW, lane, 0, W2A_S1); }
    else if (part == 4) transpose_matrix(F.w2a, DM, 2 * DFF, F.W2A, MapFfnIn{}, scr, gw, NGW, lane, W2A_S1, W2A_S2);
    else if (part == 8) transpose_matrix(F.w2a, DM, 2 * DFF, F.W2A, MapFfnIn{}, scr, gw, NGW, lane, W2A_S2);
    else if (part == 10) { transpose_matrix(F.w2b, DFF, DM, F.W2B, MapIdent{}, scr, gw, NGW, lane); wincopy_part(F, rank, nranks, 0, WIN_DB1); }
    else if (part == 11) wincopy_part(F, rank, nranks, WIN_DB1, WIN_DB2);
    else if (part == 5) wincopy_part(F, rank, nranks, WIN_DB2, NDB);
    __syncthreads();
}
DI void late_tail(Frame& F, int part, int bx, int busy) {
    if (busy % F.G == 0) late_work(F, part, bx, F.G); else if (bx >= busy % F.G) late_work(F, part, bx - busy % F.G, F.G - busy % F.G);
}
DI void ln_finish(f32x4 (&v)[8], int m, int lane, float* outf, bf16* outb, const LAS float* g, const LAS float* b) {
    float s = 0.f;
#pragma unroll
    for (int j = 0; j < 8; ++j) s += (v[j][0] + v[j][1]) + (v[j][2] + v[j][3]);
    const float mean = wave_sum(s) * (1.f / DM); float s2 = 0.f;
#pragma unroll
    for (int j = 0; j < 8; ++j) { v[j] = v[j] - mean; s2 += (v[j][0] * v[j][0] + v[j][1] * v[j][1]) + (v[j][2] * v[j][2] + v[j][3] * v[j][3]); }
    const float rstd = 1.f / sqrtf(wave_sum(s2) * (1.f / DM) + LN_EPS);
#pragma unroll
    for (int j = 0; j < 4; ++j) { const int c = 8 * (lane + 64 * j);
        const f32x4 y0 = v[2 * j] * rstd * *(const LAS f32x4*)(g + c) + *(const LAS f32x4*)(b + c), y1 = v[2 * j + 1] * rstd * *(const LAS f32x4*)(g + c + 4) + *(const LAS f32x4*)(b + c + 4);
        if (outf) { __builtin_nontemporal_store(y0, (f32x4*)(outf + (size_t)m * DM + c)); __builtin_nontemporal_store(y1, (f32x4*)(outf + (size_t)m * DM + c + 4)); }
        if (outb) *(u32x4*)(outb + (size_t)m * DM + c) = (u32x4){pk2(y0[0], y0[1]), pk2(y0[2], y0[3]), pk2(y1[0], y1[1]), pk2(y1[2], y1[3])}; }
}
DI void ln_prompt_row(const bf16* zb, int m, int mpf, u32x4 (&nq)[4], int lane, float* outf, bf16* outb, const LAS float* g, const LAS float* b) {
    f32x4 v[8];
#pragma unroll
    for (int j = 0; j < 4; ++j) { v[2 * j] = bf4_lo(nq[j]); v[2 * j + 1] = bf4_hi(nq[j]); }
    if (mpf < MP) {
#pragma unroll
        for (int j = 0; j < 4; ++j) nq[j] = *(const u32x4*)(zb + (size_t)mpf * DM + 8 * (lane + 64 * j));
    }
    ln_finish(v, m, lane, outf, outb, g, b);
}
DI void ln_phase(Frame& F, const bf16* zb, float* outf, bf16* outb, const float* gg, const float* gb, const float* res_s, const bf16* res16, float sc) {
    const int gw = F.vcu * NWAVES + F.wave, NGW = F.G * NWAVES, lane = F.lane;
    LAS float* g = (LAS float*)F.lds; LAS float* b = g + DM;
    const f32x4 g4 = *(const f32x4*)(gg + 4 * F.tid), b4 = *(const f32x4*)(gb + 4 * F.tid);
    u32x4 qa[4], qb[4], qc[4];
    if (gw < MP) {
#pragma unroll
        for (int j = 0; j < 4; ++j) qa[j] = *(const u32x4*)(zb + (size_t)gw * DM + 8 * (lane + 64 * j));
    }
    if (gw + NGW < MP) {
#pragma unroll
        for (int j = 0; j < 4; ++j) qb[j] = *(const u32x4*)(zb + (size_t)(gw + NGW) * DM + 8 * (lane + 64 * j));
    }
    if (gw + 2 * NGW < MP) {
#pragma unroll
        for (int j = 0; j < 4; ++j) qc[j] = *(const u32x4*)(zb + (size_t)(gw + 2 * NGW) * DM + 8 * (lane + 64 * j));
    }
    *(LAS f32x4*)(g + 4 * F.tid) = g4; *(LAS f32x4*)(b + 4 * F.tid) = b4;
    __syncthreads();
    for (int ms = F.vcu + F.G * F.wave; ms < MS; ms += NGW) { const size_t o = (size_t)ms * DM; f32x4 v[8];
#pragma unroll
        for (int j = 0; j < 4; ++j)
#pragma unroll
            for (int hh = 0; hh < 2; ++hh) { const size_t e = o + 8 * (lane + 64 * j) + 4 * hh; f32x4 a = *(const f32x4*)(F.SLAB + e);
#pragma unroll
                for (int q = 1; q < NSPLIT; ++q) a = a + *(const f32x4*)(F.SLAB + (size_t)q * MS * DM + e);
                f32x4 rv;
                if (res_s) rv = *(const f32x4*)(res_s + e);
                else { const u32x2 q2 = *(const u32x2*)(res16 + e); rv = (f32x4){__builtin_bit_cast(float, q2.x << 16), __builtin_bit_cast(float, q2.x & 0xffff0000u), __builtin_bit_cast(float, q2.y << 16), __builtin_bit_cast(float, q2.y & 0xffff0000u)}; }
                v[2 * j + hh] = rv * ALPHA + a * sc; }
        ln_finish(v, MP + ms, lane, outf, outb, g, b);
    }
    for (int m = gw; m < MP; m += 3 * NGW) {
        ln_prompt_row(zb, m, m + 3 * NGW, qa, lane, outf, outb, g, b);
        if (m + NGW < MP) ln_prompt_row(zb, m + NGW, m + 4 * NGW, qb, lane, outf, outb, g, b);
        if (m + 2 * NGW < MP) ln_prompt_row(zb, m + 2 * NGW, m + 5 * NGW, qc, lane, outf, outb, g, b);
    }
}

struct XOps { bf16x8 a[4]; bf16x8 b[4][4]; };
DI void xops_load(XOps& o, const bf16* ap, const bf16* bp, int k0) {
#pragma unroll
    for (int ks = 0; ks < 4; ++ks) { o.a[ks] = *(const bf16x8*)(ap + k0 + 32 * ks);
#pragma unroll
        for (int n = 0; n < 4; ++n) o.b[ks][n] = *(const bf16x8*)(bp + (size_t)n * 16 * DM + k0 + 32 * ks); }
}
DI void xops_mma(const XOps& o, f32x4 (&acc)[4]) {
#pragma unroll
    for (int ks = 0; ks < 4; ++ks)
#pragma unroll
        for (int n = 0; n < 4; ++n) acc[n] = __builtin_amdgcn_mfma_f32_16x16x32_bf16(o.a[ks], o.b[ks][n], acc[n], 0, 0, 0);
}
DI void extra_phase(Frame& F, int rank, int nranks) {
    const int lane = F.lane, w = F.wave, r = lane & 15, kq = lane >> 4, tile = w >> 2, q4 = w & 3;
    LAS float* PART = (LAS float*)F.lds;
    const bf16* Bt = F.WIN + (size_t)NIN * DM;
    for (int it = rank; it < MTOT / 32; it += nranks) {
        const bf16* ap = F.XB + (size_t)(it * 32 + tile * 16 + r) * DM + 512 * q4 + 8 * kq;
        const bf16* bp = Bt + (size_t)r * DM + 512 * q4 + 8 * kq;
        f32x4 acc[4];
#pragma unroll
        for (int n = 0; n < 4; ++n) acc[n] = (f32x4){0.f, 0.f, 0.f, 0.f};
        XOps R0, R1;
        xops_load(R0, ap, bp, 0); xops_load(R1, ap, bp, 128);
        xops_mma(R0, acc); xops_load(R0, ap, bp, 256);
        xops_mma(R1, acc); xops_load(R1, ap, bp, 384);
        xops_mma(R0, acc); xops_mma(R1, acc);
#pragma unroll
        for (int n = 0; n < 4; ++n)
#pragma unroll
            for (int i = 0; i < 4; ++i) PART[(w * 16 + 4 * kq + i) * 64 + n * 16 + r] = acc[n][i];
        __syncthreads();
        { const int t2 = F.tid >> 8, e = F.tid & 255, row = e >> 4, c4 = (e & 15) * 4;
          f32x4 s = *(const LAS f32x4*)(PART + ((t2 * 4 + 0) * 16 + row) * 64 + c4);
#pragma unroll
          for (int q = 1; q < 4; ++q) s = s + *(const LAS f32x4*)(PART + ((t2 * 4 + q) * 16 + row) * 64 + c4);
          *(f32x4*)(F.EXTRA + (size_t)(it * 32 + t2 * 16 + row) * 64 + c4) = s; }
        __syncthreads();
    }
}

DI f32x4 ldbf4(const bf16* p) { const u32x2 q = *(const u32x2*)p; return (f32x4){__builtin_bit_cast(float, q.x << 16), __builtin_bit_cast(float, q.x & 0xffff0000u), __builtin_bit_cast(float, q.y << 16), __builtin_bit_cast(float, q.y & 0xffff0000u)}; }
DI float ldbf(const bf16* p) { return __builtin_bit_cast(float, (unsigned)(*p) << 16); }
DI float log_sigmoid_(float x) { return fminf(x, 0.f) - __logf(1.f + __expf(-fabsf(x))); }
#define MFMA4(a, b, c) __builtin_amdgcn_mfma_f32_16x16x4f32((a), (b), (c), 0, 0, 0)

constexpr int GLP = 132, G_QH = 0, G_KH = G_QH + 64 * GLP, G_END = G_KH + 64 * GLP;
static_assert(G_END * 4 <= RING_BYTES && 64 * 260 <= G_END, "GLA LDS map");
constexpr int G_X0 = (MISC_OFF + 256) / 4, G_GA = G_X0, G_PART = G_GA + 64 * 16, G_XEND = G_PART + 512;
static_assert(G_XEND * 4 <= LDS_BYTES, "GLA LDS map 2");
#define MFMA16(a, b, c) __builtin_amdgcn_mfma_f32_16x16x32_bf16((a), (b), (c), 0, 0, 0)
DI bf16x8 ld8_f32_as_bf16(const LAS float* p) { const f32x4 a = *(const LAS f32x4*)p, b = *(const LAS f32x4*)(p + 4); u32x4 w; w.x = pk2(a[0], a[1]); w.y = pk2(a[2], a[3]); w.z = pk2(b[0], b[1]); w.w = pk2(b[2], b[3]); return __builtin_bit_cast(bf16x8, w); }

struct PreRegs { u32x2 q[4], k[4], v[8]; f32x4 ga; };
DI void pre_load_qk(Frame& F, PreRegs& R, int item, int tid) {
    const int c = item & 31, h = (item >> 5) & 3, b = item >> 7; const size_t row0 = (size_t)b * TT + 64 * c;
#pragma unroll
    for (int i = 0; i < 4; ++i) { const int idx = tid + 512 * i, row = idx >> 5, c4 = idx & 31; const bf16* g = F.G16 + (row0 + row) * GLAW + h * 128 + 4 * c4;
        R.q[i] = *(const u32x2*)g; R.k[i] = *(const u32x2*)(g + 512); }
    R.ga = (f32x4){0.f, 0.f, 0.f, 0.f};
    if (tid < 256) { const int row = tid >> 2, c4 = tid & 3; R.ga = *(const f32x4*)(F.EXTRA + (row0 + row) * 64 + 4 * c4); }
}
DI void pre_load_v(Frame& F, PreRegs& R, int item, int tid) {
    const int c = item & 31, h = (item >> 5) & 3, b = item >> 7; const size_t row0 = (size_t)b * TT + 64 * c;
#pragma unroll
    for (int i = 0; i < 8; ++i) { const int idx = tid + 512 * i, row = idx >> 6, c4 = idx & 63; R.v[i] = *(const u32x2*)(F.G16 + (row0 + row) * GLAW + 1024 + h * 256 + 4 * c4); }
}
DI f32x4 bf2x2(u32x2 q) { return (f32x4){__builtin_bit_cast(float, q.x << 16), __builtin_bit_cast(float, q.x & 0xffff0000u), __builtin_bit_cast(float, q.y << 16), __builtin_bit_cast(float, q.y & 0xffff0000u)}; }
DI void gla_pre_item(Frame& F, int item, PreRegs& R, int nxt) {
    LAS float* L = (LAS float*)F.lds;
    LAS float *QH = L + G_QH, *KH = L + G_KH, *VS = L, *GA = L + G_GA, *PART = L + G_PART;
    const int tid = F.tid, lane = F.lane, w = F.wave, r16 = lane & 15, kq = lane >> 4;
    const int h = (item >> 5) & 3;
    const int kk = tid & 127, tq = tid >> 7;
    __syncthreads();
#pragma unroll
    for (int i = 0; i < 4; ++i) { const int idx = tid + 512 * i, row = idx >> 5, c4 = idx & 31; *(LAS f32x4*)(QH + row * GLP + 4 * c4) = bf2x2(R.q[i]); *(LAS f32x4*)(KH + row * GLP + 4 * c4) = bf2x2(R.k[i]); }
    if (tid < 256) { const int row = tid >> 2, c4 = tid & 3; *(LAS f32x4*)(GA + row * 16 + 4 * c4) = R.ga; }
    float w2r[16];
#pragma unroll
    for (int r = 0; r < 16; ++r) w2r[r] = F.w_g2[r * 512 + h * 128 + kk];
    const float b2 = F.b_g2[h * 128 + kk];
    __syncthreads();
    float cum[16]; float run = 0.f;
#pragma unroll
    for (int i = 0; i < 16; ++i) { const int t = 16 * tq + i; float x = b2;
#pragma unroll
        for (int r = 0; r < 16; ++r) x += GA[t * 16 + r] * w2r[r];
        run += log_sigmoid_(x) * (1.f / 16.f); cum[i] = run; }
    PART[tq * 128 + kk] = run;
    __syncthreads();
    float off = 0.f;
#pragma unroll
    for (int j = 0; j < 3; ++j) off += (j < tq) ? PART[j * 128 + kk] : 0.f;
#pragma unroll
    for (int i = 0; i < 16; ++i) { const int t = 16 * tq + i; const float e = __expf(cum[i] + off); QH[t * GLP + kk] *= e; KH[t * GLP + kk] *= frcp(e); }
    if (tq == 3) F.GD[(size_t)item * 128 + kk] = __expf(cum[15] + off);
    __syncthreads();
    if (nxt >= 0) pre_load_qk(F, R, nxt, tid);
    { const int row = tid >> 3, c0 = (tid & 7) * 16; bf16* dst = F.GQ + ((size_t)item * 64 + row) * 128 + c0;
      *(bf16x8*)dst = ld8_f32_as_bf16(QH + row * GLP + c0); *(bf16x8*)(dst + 8) = ld8_f32_as_bf16(QH + row * GLP + c0 + 8); }
    { const int k = tid >> 2, j0 = (tid & 3) * 16; float v[16];
#pragma unroll
      for (int j = 0; j < 16; ++j) v[j] = KH[(j0 + j) * GLP + k];
      u32x4 a, bq; a.x = pk2(v[0], v[1]); a.y = pk2(v[2], v[3]); a.z = pk2(v[4], v[5]); a.w = pk2(v[6], v[7]); bq.x = pk2(v[8], v[9]); bq.y = pk2(v[10], v[11]); bq.z = pk2(v[12], v[13]); bq.w = pk2(v[14], v[15]);
      bf16* dst = F.GKT + ((size_t)item * 128 + k) * 64 + j0; *(u32x4*)dst = a; *(u32x4*)(dst + 8) = bq; }
#pragma unroll
    for (int q = 0; q < 2; ++q) { const int tile = 2 * w + q, ti = tile >> 2, tj = tile & 3;
        f32x4 a = {0.f, 0.f, 0.f, 0.f};
        if (tj <= ti) {
#pragma unroll
            for (int s = 0; s < 4; ++s) a = MFMA16(ld8_f32_as_bf16(KH + (16 * tj + r16) * GLP + 32 * s + 8 * kq), ld8_f32_as_bf16(QH + (16 * ti + r16) * GLP + 32 * s + 8 * kq), a);
        }
        const int ri = 16 * ti + r16, cj = 16 * tj + 4 * kq;
        *(u32x2*)(F.GA + ((size_t)item * 64 + ri) * 64 + cj) = (u32x2){pk2(cj <= ri ? a[0] : 0.f, cj + 1 <= ri ? a[1] : 0.f), pk2(cj + 2 <= ri ? a[2] : 0.f, cj + 3 <= ri ? a[3] : 0.f)};
    }
    __syncthreads();
#pragma unroll
    for (int i = 0; i < 8; ++i) { const int idx = tid + 512 * i, row = idx >> 6, c4 = idx & 63; *(LAS f32x4*)(VS + row * 260 + 4 * c4) = bf2x2(R.v[i]); }
    if (nxt >= 0) pre_load_v(F, R, nxt, tid);
    __syncthreads();
    { const int v = tid >> 1, j0 = (tid & 1) * 32; bf16* dst = F.GVT + ((size_t)item * 256 + v) * 64 + j0;
#pragma unroll
      for (int g = 0; g < 4; ++g) { float x[8];
#pragma unroll
          for (int j = 0; j < 8; ++j) x[j] = VS[(j0 + 8 * g + j) * 260 + v];
          u32x4 a; a.x = pk2(x[0], x[1]); a.y = pk2(x[2], x[3]); a.z = pk2(x[4], x[5]); a.w = pk2(x[6], x[7]); *(u32x4*)(dst + 8 * g) = a; } }
}

struct GlaOps { bf16x8 aA0, aA1, aQ0, aQ1, aQ2, aQ3, bK0, bK1; u32x4 vs; float dD; };
DI void gla_seq_load(Frame& F, GlaOps& o, int item, int vs, int w, int r16, int kq, int tid) {
    const int ti = w >> 1;
    const bf16* ga = F.GA + ((size_t)item * 64 + 16 * ti + r16) * 64 + 8 * kq; const bf16* gq = F.GQ + ((size_t)item * 64 + 16 * ti + r16) * 128 + 8 * kq;
    const bf16* gk = F.GKT + ((size_t)item * 128 + 16 * w + r16) * 64 + 8 * kq;
    o.aA0 = *(const bf16x8*)ga; o.aA1 = *(const bf16x8*)(ga + 32); o.bK0 = *(const bf16x8*)gk; o.bK1 = *(const bf16x8*)(gk + 32);
    o.aQ0 = *(const bf16x8*)gq; o.aQ1 = *(const bf16x8*)(gq + 32); o.aQ2 = *(const bf16x8*)(gq + 64); o.aQ3 = *(const bf16x8*)(gq + 96);
    o.vs = *(const u32x4*)(F.GVT + ((size_t)item * 256 + 64 * vs) * 64 + tid * 8);
    o.dD = F.GD[(size_t)item * 128 + 16 * w + r16];
}
DI void gla_seq_step(Frame& F, const GlaOps& cur, const GlaOps& nxt, f32x4 (&acc)[4], LAS bf16* ST, int b, int h, int vs, int c, int w, int r16, int kq, int tid) {
    const int ti = w >> 1, tp = w & 1;
    const LAS bf16* Sc = ST + (c & 1) * 64 * 136; LAS bf16* Sn = ST + ((c & 1) ^ 1) * 64 * 136;
    const LAS bf16* Vc = (const LAS bf16*)((LAS unsigned char*)ST + 69632) + (c & 1) * 64 * 72; LAS bf16* Vn = (LAS bf16*)((LAS unsigned char*)ST + 69632) + ((c & 1) ^ 1) * 64 * 72;
    *(LAS u32x4*)(Vn + (tid >> 3) * 72 + (tid & 7) * 8) = nxt.vs;
    f32x4 o0 = {0.f, 0.f, 0.f, 0.f}, o1 = o0;
    { const LAS bf16* vp = Vc + (32 * tp + r16) * 72 + 8 * kq;
      o0 = MFMA16(cur.aA0, *(const LAS bf16x8*)vp, o0); o0 = MFMA16(cur.aA1, *(const LAS bf16x8*)(vp + 32), o0);
      o1 = MFMA16(cur.aA0, *(const LAS bf16x8*)(vp + 16 * 72), o1); o1 = MFMA16(cur.aA1, *(const LAS bf16x8*)(vp + 16 * 72 + 32), o1); }
    { const LAS bf16* sp = Sc + (32 * tp + r16) * 136 + 8 * kq;
      o0 = MFMA16(cur.aQ0, *(const LAS bf16x8*)sp, o0); o0 = MFMA16(cur.aQ1, *(const LAS bf16x8*)(sp + 32), o0); o0 = MFMA16(cur.aQ2, *(const LAS bf16x8*)(sp + 64), o0); o0 = MFMA16(cur.aQ3, *(const LAS bf16x8*)(sp + 96), o0);
      sp += 16 * 136;
      o1 = MFMA16(cur.aQ0, *(const LAS bf16x8*)sp, o1); o1 = MFMA16(cur.aQ1, *(const LAS bf16x8*)(sp + 32), o1); o1 = MFMA16(cur.aQ2, *(const LAS bf16x8*)(sp + 64), o1); o1 = MFMA16(cur.aQ3, *(const LAS bf16x8*)(sp + 96), o1); }
    { LAS float* ob = (LAS float*)(ST + 2 * 64 * 136) + (c & 1) * 64 * 68 + (16 * ti + 4 * kq) * 68 + 32 * tp + r16;
#pragma unroll
      for (int i = 0; i < 4; ++i) { ob[i * 68] = o0[i]; ob[i * 68 + 16] = o1[i]; } }
#pragma unroll
    for (int tv = 0; tv < 4; ++tv) { const LAS bf16* vp = Vc + (16 * tv + r16) * 72 + 8 * kq;
        acc[tv] = MFMA16(*(const LAS bf16x8*)vp, cur.bK0, acc[tv]); acc[tv] = MFMA16(*(const LAS bf16x8*)(vp + 32), cur.bK1, acc[tv]); acc[tv] = acc[tv] * cur.dD; }
#pragma unroll
    for (int tv = 0; tv < 4; ++tv)
#pragma unroll
        for (int i = 0; i < 4; ++i) Sn[(16 * tv + 4 * kq + i) * 136 + 16 * w + r16] = (bf16)(pk2(acc[tv][i], 0.f) & 0xffffu);
    __syncthreads();
}
DI void gla_seq_flush(Frame& F, LAS bf16* ST, int b, int h, int vs, int c) {
    const int row = F.tid >> 3, seg = F.tid & 7;
    const LAS float* ob = (const LAS float*)(ST + 2 * 64 * 136) + (c & 1) * 64 * 68 + row * 68 + 4 * seg;
    float* op = F.ORAW + ((size_t)b * TT + 64 * c + row) * 1024 + h * 256 + 64 * vs + 4 * seg;
    *(f32x4*)op = *(const LAS f32x4*)ob; *(f32x4*)(op + 32) = *(const LAS f32x4*)(ob + 32);
}
DI void gla_seq_unit(Frame& F, int b, int h, int vs) {
    LAS bf16* ST = (LAS bf16*)F.lds;
    int tid_ = F.tid; asm volatile("" : "+v"(tid_));
    const int tid = tid_, lane = tid & 63, w = F.wave, r16 = lane & 15, kq = lane >> 4;
    __syncthreads();
    for (int i = tid; i < 2 * 64 * 136 / 2; i += 512) ((LAS unsigned*)ST)[i] = 0u;
    f32x4 acc[4];
#pragma unroll
    for (int tv = 0; tv < 4; ++tv) acc[tv] = (f32x4){0.f, 0.f, 0.f, 0.f};
    const int item0 = (b * 4 + h) * 32;
    GlaOps R0, R1, R2;
    gla_seq_load(F, R0, item0, vs, w, r16, kq, tid); gla_seq_load(F, R1, item0 + 1, vs, w, r16, kq, tid);
    *(LAS u32x4*)((LAS bf16*)((LAS unsigned char*)ST + 69632) + (tid >> 3) * 72 + (tid & 7) * 8) = R0.vs;
    __syncthreads();
#pragma unroll 1
    for (int c = 0; c < 30; c += 3) {
        gla_seq_load(F, R2, item0 + c + 2, vs, w, r16, kq, tid); if (c > 0) gla_seq_flush(F, ST, b, h, vs, c - 1); gla_seq_step(F, R0, R1, acc, ST, b, h, vs, c, w, r16, kq, tid);
        gla_seq_load(F, R0, item0 + c + 3, vs, w, r16, kq, tid); gla_seq_flush(F, ST, b, h, vs, c);     gla_seq_step(F, R1, R2, acc, ST, b, h, vs, c + 1, w, r16, kq, tid);
        gla_seq_load(F, R1, item0 + (c + 4 < 32 ? c + 4 : 31), vs, w, r16, kq, tid); gla_seq_flush(F, ST, b, h, vs, c + 1); gla_seq_step(F, R2, R0, acc, ST, b, h, vs, c + 2, w, r16, kq, tid);
    }
    gla_seq_flush(F, ST, b, h, vs, 29); gla_seq_step(F, R0, R1, acc, ST, b, h, vs, 30, w, r16, kq, tid);
    gla_seq_flush(F, ST, b, h, vs, 30); gla_seq_step(F, R1, R1, acc, ST, b, h, vs, 31, w, r16, kq, tid);
    gla_seq_flush(F, ST, b, h, vs, 31);
#pragma unroll
    for (int tv = 0; tv < 4; ++tv)
#pragma unroll
        for (int i = 0; i < 4; ++i) F.out[O_GLAP + ((size_t)(b * 4 + h) * 128 + 16 * w + r16) * 256 + 64 * vs + 16 * tv + 4 * kq + i] = acc[tv][i];
}

DI void gla_sample_unit(Frame& F, int db, int h) {
    LAS float* L = (LAS float*)F.lds;
    LAS float *QH = L, *KH = L + 1024, *VV = L + 2048, *AA = L + 4096, *DD = L + 4160, *GA = L + 4288, *OP = L + 4416;
    const int tid = F.tid, lane = F.lane, w = F.wave;
    const size_t row0 = (size_t)MP + db * 8;
    __syncthreads();
    for (int i = tid; i < 8 * 128; i += 512) { const int t = i >> 7, k = i & 127; QH[i] = ldbf(F.G16 + (row0 + t) * GLAW + h * 128 + k); KH[i] = ldbf(F.G16 + (row0 + t) * GLAW + 512 + h * 128 + k); }
    for (int i = tid; i < 8 * 256; i += 512) { const int t = i >> 8, v = i & 255; VV[i] = ldbf(F.G16 + (row0 + t) * GLAW + 1024 + h * 256 + v); }
    if (tid < 128) GA[tid] = F.EXTRA[(row0 + (tid >> 4)) * 64 + (tid & 15)];
    __syncthreads();
    if (tid < 128) { const int k = tid; float run = 0.f;
        float w2r[16];
#pragma unroll
        for (int r = 0; r < 16; ++r) w2r[r] = F.w_g2[r * 512 + h * 128 + k];
        const float b2 = F.b_g2[h * 128 + k];
#pragma unroll
        for (int t = 0; t < 8; ++t) { float x = b2;
#pragma unroll
            for (int r = 0; r < 16; ++r) x += GA[t * 16 + r] * w2r[r];
            run += log_sigmoid_(x) * (1.f / 16.f); const float e = __expf(run); QH[t * 128 + k] *= e; KH[t * 128 + k] *= frcp(e); }
        DD[k] = __expf(run); }
    __syncthreads();
    if (tid < 64) { const int i = tid >> 3, j = tid & 7; float a = 0.f;
        if (j <= i) for (int k = 0; k < 128; ++k) a += QH[i * 128 + k] * KH[j * 128 + k];
        AA[tid] = a; }
    __syncthreads();
    const int c4 = 4 * lane;
    f32x4 v[8], o[8];
#pragma unroll
    for (int t = 0; t < 8; ++t) { v[t] = *(const LAS f32x4*)(VV + t * 256 + c4); o[t] = (f32x4){0.f, 0.f, 0.f, 0.f}; }
    const float* S0 = F.st_gla + ((size_t)(db * 4 + h) * 128 + 16 * w) * 256 + c4;
    float* S1 = F.out + O_GLAS + ((size_t)(db * 4 + h) * 128 + 16 * w) * 256 + c4;
    f32x4 sv[16];
#pragma unroll
    for (int k = 0; k < 16; ++k) sv[k] = __builtin_nontemporal_load((const f32x4*)(S0 + (size_t)k * 256));
#pragma unroll
    for (int k = 0; k < 16; ++k) { const int kk = 16 * w + k; const f32x4 s = sv[k]; f32x4 acc = s;
#pragma unroll
        for (int t = 0; t < 8; ++t) { o[t] = o[t] + QH[t * 128 + kk] * s; acc = acc + KH[t * 128 + kk] * v[t]; }
        __builtin_nontemporal_store(acc * DD[kk], (f32x4*)(S1 + (size_t)k * 256)); }
#pragma unroll
    for (int t = 0; t < 8; ++t) *(LAS f32x4*)(OP + (w * 8 + t) * 256 + c4) = o[t];
    __syncthreads();
    { const int t = tid >> 6; float ov[4]; float ss = 0.f;
#pragma unroll
        for (int q = 0; q < 4; ++q) { const int cc = lane + 64 * q; float x = 0.f;
#pragma unroll
            for (int g = 0; g < 8; ++g) x += OP[(g * 8 + t) * 256 + cc];
#pragma unroll
            for (int j = 0; j < 8; ++j) x += AA[t * 8 + j] * VV[j * 256 + cc];
            ov[q] = x; ss += x * x; }
        ss = wave_sum(ss); const float rs = 1.f / sqrtf(ss * (1.f / 256.f) + LN_EPS);
#pragma unroll
        for (int q = 0; q < 4; ++q) { const int cc = lane + 64 * q; const float gr = ldbf(F.G16 + (row0 + t) * GLAW + 2048 + h * 256 + cc);
            const float y = ov[q] * rs * F.gnorm[cc] * siluf_(gr);
            F.MIX[(row0 + t) * DM + h * 256 + cc] = (bf16)(pk2(y, 0.f) & 0xffffu); }
    }
    __syncthreads();
}

DI void gla_finalize_phase(Frame& F) {
    int lane = F.lane; asm volatile("" : "+v"(lane));
    const int gw = F.vcu * NWAVES + F.wave, NGW = F.G * NWAVES;
    const f32x4 gn = *(const f32x4*)(F.gnorm + 4 * lane);
    for (int it0 = 4 * gw; it0 < MP * 4; it0 += 4 * NGW) {
        const int row = it0 >> 2;
        f32x4 o[4], gr[4];
#pragma unroll
        for (int h = 0; h < 4; ++h) { o[h] = *(const f32x4*)(F.ORAW + (size_t)row * 1024 + h * 256 + 4 * lane); gr[h] = ldbf4(F.G16 + (size_t)row * GLAW + 2048 + h * 256 + 4 * lane); }
#pragma unroll
        for (int h = 0; h < 4; ++h) {
            const float ss = wave_sum((o[h][0] * o[h][0] + o[h][1] * o[h][1]) + (o[h][2] * o[h][2] + o[h][3] * o[h][3]));
            const float rs = 1.f / sqrtf(ss * (1.f / 256.f) + LN_EPS);
            u32x2 wv; wv.x = pk2(o[h][0] * rs * gn[0] * siluf_(gr[h][0]), o[h][1] * rs * gn[1] * siluf_(gr[h][1])); wv.y = pk2(o[h][2] * rs * gn[2] * siluf_(gr[h][2]), o[h][3] * rs * gn[3] * siluf_(gr[h][3]));
            *(u32x2*)(F.MIX + (size_t)row * DM + h * 256 + 4 * lane) = wv; }
    }
}

DI float gelu_tanh_(float x) { const float u = 0.7978845608028654f * (x + 0.044715f * x * x * x); const float e = fexp2(2.f * u * LOG2E); const float th = 1.f - 2.f * frcp(e + 1.f); return 0.5f * x * (1.f + th); }
DI void zc_load(const bf16* Z, u32x4 (&za)[4], u32x4 (&zb)[4], int tid) {
    const int n8 = (tid & 15) * 8, i0 = tid >> 4;
#pragma unroll
    for (int q = 0; q < 4; ++q) { const int i = i0 + 32 * q; za[q] = *(const u32x4*)(Z + (size_t)i * 256 + n8); zb[q] = *(const u32x4*)(Z + (size_t)(i < 127 ? i + 1 : i) * 256 + 128 + n8); }
}
DI float bflo(unsigned u) { return __builtin_bit_cast(float, u << 16); }
DI float bfhi(unsigned u) { return __builtin_bit_cast(float, u & 0xffff0000u); }
DI void zcombine_phase(Frame& F, int rank, int nranks) {
    LAS bf16* W2T = (LAS bf16*)F.lds; LAS bf16* Y = (LAS bf16*)(F.lds + 34816);
    const int tid = F.tid, lane = F.lane, w = F.wave, r16 = lane & 15, kq = lane >> 4;
    const bf16* ZB = (const bf16*)F.ZC;
    __syncthreads();
    for (int e = tid; e < 2 * 128 * 64; e += 512) { const int kv = e >> 13, n = (e >> 6) & 127, d = e & 63; W2T[(kv * 64 + d) * 136 + n] = (bf16)(pk2(F.cw2[e], 0.f) & 0xffffu); }
    const int ngroups = 2 * NSEQ * 4;
    u32x4 za[4], zb[4];
    int gidx = rank;
    if (gidx < ngroups) zc_load(ZB + (size_t)gidx * 128 * 256, za, zb, tid);
    __syncthreads();
    for (; gidx < ngroups; gidx += nranks) {
        const int kv = gidx / (NSEQ * 4), sh = gidx % (NSEQ * 4);
        { const int n8 = (tid & 15) * 8, i0 = tid >> 4; const f32x4 cb0 = *(const f32x4*)(F.CBIAS + kv * 128 + n8), cb1 = *(const f32x4*)(F.CBIAS + kv * 128 + n8 + 4);
#pragma unroll
          for (int q = 0; q < 4; ++q) { const int i = i0 + 32 * q; float y[8];
              y[0] = bflo(za[q].x) + bflo(zb[q].x) + cb0[0]; y[1] = bfhi(za[q].x) + bfhi(zb[q].x) + cb0[1]; y[2] = bflo(za[q].y) + bflo(zb[q].y) + cb0[2]; y[3] = bfhi(za[q].y) + bfhi(zb[q].y) + cb0[3];
              y[4] = bflo(za[q].z) + bflo(zb[q].z) + cb1[0]; y[5] = bfhi(za[q].z) + bfhi(zb[q].z) + cb1[1]; y[6] = bflo(za[q].w) + bflo(zb[q].w) + cb1[2]; y[7] = bfhi(za[q].w) + bfhi(zb[q].w) + cb1[3];
#pragma unroll
              for (int j = 0; j < 8; ++j) y[j] = (i == 127) ? 0.f : gelu_tanh_(y[j]);
              *(LAS u32x4*)(Y + i * 136 + n8) = (u32x4){pk2(y[0], y[1]), pk2(y[2], y[3]), pk2(y[4], y[5]), pk2(y[6], y[7])}; } }
        __syncthreads();
        if (gidx + nranks < ngroups) zc_load(ZB + (size_t)(gidx + nranks) * 128 * 256, za, zb, tid);
        f32x4 acc[4];
#pragma unroll
        for (int t = 0; t < 4; ++t) acc[t] = (f32x4){0.f, 0.f, 0.f, 0.f};
#pragma unroll
        for (int s = 0; s < 4; ++s) { const bf16x8 yb = *(const LAS bf16x8*)(Y + (16 * w + r16) * 136 + 32 * s + 8 * kq);
#pragma unroll
            for (int t = 0; t < 4; ++t) acc[t] = __builtin_amdgcn_mfma_f32_16x16x32_bf16(*(const LAS bf16x8*)(W2T + (kv * 64 + 16 * t + r16) * 136 + 32 * s + 8 * kq), yb, acc[t], 0, 0, 0); }
        { bf16* dst = (kv == 0 ? F.KC16 : F.VCT16) + ((size_t)sh * 128 + 16 * w + r16) * 64 + 4 * kq;
#pragma unroll
          for (int t = 0; t < 4; ++t) *(u32x2*)(dst + 16 * t) = (u32x2){pk2(acc[t][0], acc[t][1]), pk2(acc[t][2], acc[t][3])}; }
        __syncthreads();
    }
}

#define MFMA32(a, b, c) __builtin_amdgcn_mfma_f32_32x32x16_bf16((a), (b), (c), 0, 0, 0)
struct AState { float m, l; f32x16 o0, o1; };
DI f32x16 zero16() { f32x16 z;
#pragma unroll
    for (int i = 0; i < 16; ++i) z[i] = 0.f; return z; }
DI void astate_init(AState& s) { s.m = -1e30f; s.l = 0.f; s.o0 = zero16(); s.o1 = zero16(); }
DI f32x16 qk_tile32(const LAS bf16* Kt, int KP, const bf16x8 (&qf)[4], int r, int h) {
    f32x16 acc = zero16();
#pragma unroll
    for (int s = 0; s < 4; ++s) { const bf16x8 kf = *(const LAS bf16x8*)(Kt + r * KP + 16 * s + 8 * h); acc = MFMA32(kf, qf[s], acc); }
    return acc;
}
typedef short v4i16_t __attribute__((ext_vector_type(4)));
DI s16x4 lds_tr(const LAS bf16* p) { return __builtin_bit_cast(s16x4, __builtin_amdgcn_ds_read_tr16_b64_v4i16((LAS v4i16_t*)p)); }
DI void pv_tile32(f32x16& o0, f32x16& o1, const LAS bf16* Vr, int VP, const f32x16& p, int lane) {
    const int h = lane >> 5, blk = (lane >> 4) & 1, q = (lane & 15) >> 2, pp = lane & 3;
    const LAS bf16* base = Vr + (4 * h + q) * VP + 16 * blk + 4 * pp;
#pragma unroll
    for (int s = 0; s < 2; ++s) {
        u32x4 pw; pw.x = pk2(p[8 * s], p[8 * s + 1]); pw.y = pk2(p[8 * s + 2], p[8 * s + 3]); pw.z = pk2(p[8 * s + 4], p[8 * s + 5]); pw.w = pk2(p[8 * s + 6], p[8 * s + 7]);
        const bf16x8 pf = __builtin_bit_cast(bf16x8, pw);
        { const s16x4 lo = lds_tr(base + 16 * s * VP), hi = lds_tr(base + (16 * s + 8) * VP);
          o0 = MFMA32(__builtin_shufflevector(lo, hi, 0, 1, 2, 3, 4, 5, 6, 7), pf, o0); }
        { const s16x4 lo = lds_tr(base + 16 * s * VP + 32), hi = lds_tr(base + (16 * s + 8) * VP + 32);
          o1 = MFMA32(__builtin_shufflevector(lo, hi, 0, 1, 2, 3, 4, 5, 6, 7), pf, o1); }
    }
}
DI float xhalf_max(float v) { return fmaxf(v, __shfl_xor(v, 32)); }
DI float xhalf_sum(float v) { return v + __shfl_xor(v, 32); }
DI void block_online(AState& st, const LAS bf16* Kt, int KP, const LAS bf16* Vt, int VP, const bf16x8 (&qf)[4], int kbase, int lo, int hi, bool flag, int r, int h) {
    const bool any = flag && (kbase + 63 >= lo) && (kbase <= hi);
    if (__ballot(any) == 0ull) return;
    f32x16 s0 = qk_tile32(Kt, KP, qf, r, h); __builtin_amdgcn_sched_barrier(0);
    f32x16 s1 = qk_tile32(Kt + 32 * KP, KP, qf, r, h); __builtin_amdgcn_sched_barrier(0);
    const bool cut = flag && !((kbase >= lo) && (kbase + 63 <= hi));
    float mx = -__builtin_inff();
    if (__ballot(cut) != 0ull) {
        const unsigned t0 = (unsigned)(kbase + 4 * h - lo), range = (unsigned)(hi - lo);
#pragma unroll
        for (int reg = 0; reg < 16; ++reg) { const unsigned o = (unsigned)((reg & 3) + 8 * (reg >> 2));
            s0[reg] = (t0 + o <= range) ? s0[reg] : -__builtin_inff(); s1[reg] = (t0 + 32u + o <= range) ? s1[reg] : -__builtin_inff(); mx = fmaxf(mx, fmaxf(s0[reg], s1[reg])); }
    } else {
#pragma unroll
        for (int reg = 0; reg < 16; ++reg) mx = fmaxf(mx, fmaxf(s0[reg], s1[reg]));
    }
    mx = any ? mx : -__builtin_inff();
    mx = xhalf_max(mx);
    const float mn = fmaxf(st.m, mx);
    if (__ballot(mx > st.m) != 0ull) {
        const float alpha = fexp2((st.m - mn) * LOG2E);
        st.l = st.l * alpha; st.o0 = st.o0 * alpha; st.o1 = st.o1 * alpha; st.m = mn;
    }
    const float bias = any ? -mn * LOG2E : -__builtin_inff();
    float sum = 0.f;
#pragma unroll
    for (int reg = 0; reg < 16; ++reg) { s0[reg] = fexp2(__builtin_fmaf(s0[reg], LOG2E, bias)); s1[reg] = fexp2(__builtin_fmaf(s1[reg], LOG2E, bias)); sum += s0[reg] + s1[reg]; }
    st.l += xhalf_sum(sum);
    __builtin_amdgcn_sched_barrier(0);
    pv_tile32(st.o0, st.o1, Vt, VP, s0, r + 32 * h);
    __builtin_amdgcn_sched_barrier(0);
    pv_tile32(st.o0, st.o1, Vt + 32 * VP, VP, s1, r + 32 * h);
}
DI void tile_online(AState& st, const LAS bf16* Kt, int KP, const LAS bf16* Vt, int VP, const bf16x8 (&qf)[4], int kbase, int lo, int hi, bool flag, int r, int h) {
    const bool any = flag && (kbase + 31 >= lo) && (kbase <= hi);
    if (__ballot(any) == 0ull) return;
    f32x16 s = qk_tile32(Kt, KP, qf, r, h);
    const bool cut = flag && !((kbase >= lo) && (kbase + 31 <= hi));
    float mx = -__builtin_inff();
    if (__ballot(cut) != 0ull) {
        const unsigned t0 = (unsigned)(kbase + 4 * h - lo), range = (unsigned)(hi - lo);
#pragma unroll
        for (int reg = 0; reg < 16; ++reg) { s[reg] = (t0 + (unsigned)((reg & 3) + 8 * (reg >> 2)) <= range) ? s[reg] : -__builtin_inff(); mx = fmaxf(mx, s[reg]); }
    } else {
#pragma unroll
        for (int reg = 0; reg < 16; ++reg) mx = fmaxf(mx, s[reg]);
    }
    mx = any ? mx : -__builtin_inff();
    mx = xhalf_max(mx);
    if (__ballot(mx > st.m + 5.5f) != 0ull) {
        const float mn2 = fmaxf(st.m, mx), alpha = fexp2((st.m - mn2) * LOG2E);
        st.l = st.l * alpha; st.o0 = st.o0 * alpha; st.o1 = st.o1 * alpha; st.m = mn2;
    }
    const float mn = st.m;
    const float bias = any ? -mn * LOG2E : -__builtin_inff();
    f32x2 sum2 = {0.f, 0.f}; const f32x2 b2 = {bias, bias}, l2 = {LOG2E, LOG2E};
#pragma unroll
    for (int reg = 0; reg < 16; reg += 2) { f32x2 t = {s[reg], s[reg + 1]}; t = __builtin_elementwise_fma(t, l2, b2);
        t[0] = fexp2(t[0]); t[1] = fexp2(t[1]); s[reg] = t[0]; s[reg + 1] = t[1]; sum2 = sum2 + t; }
    st.l += xhalf_sum(sum2[0] + sum2[1]);
    pv_tile32(st.o0, st.o1, Vt, VP, s, r + 32 * h);
}

constexpr int KTP = 72, VTP = 72;
struct StageRegs { u32x4 k, v; };
DI StageRegs stage_load(const bf16* kp, const bf16* vp, int tid) { StageRegs g; g.k = *(const u32x4*)(kp + tid * 8); g.v = *(const u32x4*)(vp + tid * 8); return g; }
DI void stage_store(LAS bf16* KT, LAS bf16* VT, const StageRegs& g, int tid) {
    *(LAS u32x4*)(KT + (tid >> 3) * KTP + (tid & 7) * 8) = g.k; *(LAS u32x4*)(VT + (tid >> 3) * VTP + (tid & 7) * 8) = g.v;
}
DI unsigned select_blocks_wave(LAS float* SC, LAS float* SCI, int lane, int tpos_base, int cur_of_tok0, bool sample) {
    const int tok = lane >> 3, sub = lane & 7;
    const int tpos = tpos_base + tok;
    const int cur = sample ? 32 : (tpos >> 6);
    (void)cur_of_tok0;
    LAS unsigned* SCU = (LAS unsigned*)SCI;
    unsigned long long my[4];
#pragma unroll
    for (int i = 0; i < 4; ++i) { const int s = 4 * sub + i; float v = 0.f;
#pragma unroll
        for (int g = 0; g < 4; ++g) v += SC[(4 * tok + g) * 33 + s] * SC[32 * 33 + 4 * tok + g];
        const bool started = (64 * s <= tpos), forced = (s == 0) || (s == cur) || (s == cur - 1);
        const float sc = started ? (forced ? 1e9f : v) : -1e9f;
        const unsigned bits = __builtin_bit_cast(unsigned, sc), key = (bits & 0x80000000u) ? ~bits : (bits | 0x80000000u);
        SCU[tok * 33 + s] = key; my[i] = ((unsigned long long)key << 5) | (unsigned)(31 - s); }
    __syncthreads();
    unsigned bits = 0u;
    int rank[4];
#pragma unroll
    for (int i = 0; i < 4; ++i) rank[i] = sample ? 1 : 0;
#pragma unroll 8
    for (int sp = 0; sp < 32; ++sp) { const unsigned long long o = ((unsigned long long)SCU[tok * 33 + sp] << 5) | (unsigned)(31 - sp);
#pragma unroll
        for (int i = 0; i < 4; ++i) rank[i] += (o > my[i]) ? 1 : 0; }
    const unsigned long long kmin = ((unsigned long long)0x4E6E6B28u) << 5;
    (void)kmin;
#pragma unroll
    for (int i = 0; i < 4; ++i) { const int s = 4 * sub + i; if (rank[i] < 16 && (64 * s <= tpos)) bits |= 1u << s; }
    bits |= __shfl_xor(bits, 1); bits |= __shfl_xor(bits, 2); bits |= __shfl_xor(bits, 4);
    return __shfl(bits, 8 * ((lane & 31) >> 2));
}

DI void nsa_prompt_unit(Frame& F, int b, int kv, int c) {
    LAS bf16* KT0 = (LAS bf16*)(F.lds), *VT0 = (LAS bf16*)(F.lds + 9216), *KT1 = (LAS bf16*)(F.lds + 18432), *VT1 = (LAS bf16*)(F.lds + 27648);
    LAS float* SC = (LAS float*)(F.lds + 36864 + F.wave * 4480); LAS float* SCI = (LAS float*)(F.lds + 72704 + F.wave * 1056);
    int tid_ = F.tid; asm volatile("" : "+v"(tid_));
    const int tid = tid_, lane = tid & 63, w = F.wave, r = lane & 31, h = lane >> 5;
    const int tok = 64 * c + 8 * w + (r >> 2), g = r & 3, head = kv * 4 + g, qpos = tok;
    const size_t row = (size_t)b * TT + tok;
    bf16x8 qf[4];
#pragma unroll
    for (int s = 0; s < 4; ++s) qf[s] = *(const bf16x8*)(F.NQ + row * 1024 + head * 64 + 16 * s + 8 * h);
    f32x16 out0, out1;
    const float gx0 = F.EXTRA[row * 64 + 16 + head * 3], gx1 = F.EXTRA[row * 64 + 16 + head * 3 + 1], gx2 = F.EXTRA[row * 64 + 16 + head * 3 + 2];
    __syncthreads();
    unsigned selmask;
    {
        const bf16* kc = F.KC16 + ((size_t)(NDB + b) * 4 + kv) * 128 * 64; const bf16* vc = F.VCT16 + ((size_t)(NDB + b) * 4 + kv) * 128 * 64;
        { const StageRegs a = stage_load(kc, vc, tid), bq = stage_load(kc + 64 * 64, vc + 64 * 64, tid); stage_store(KT0, VT0, a, tid); stage_store(KT1, VT1, bq, tid); }
        __syncthreads();
        int hin = (qpos - 31) >> 4; hin = hin > 126 ? 126 : hin;
        float mx = -1e30f;
#pragma unroll
        for (int q = 0; q < 4; ++q) { const f32x16 sq = qk_tile32((q < 2 ? KT0 : KT1) + (q & 1) * 32 * KTP, KTP, qf, r, h);
#pragma unroll
            for (int reg = 0; reg < 16; ++reg) { const int n = 32 * q + 4 * h + (reg & 3) + 8 * (reg >> 2); mx = fmaxf(mx, (n <= hin) ? sq[reg] : -1e30f); }
            __builtin_amdgcn_sched_barrier(0); }
        mx = fmaxf(mx, __shfl_xor(mx, 32));
        float sum = 0.f; float edge[16];
        f32x16 o0 = zero16(), o1 = zero16();
#pragma unroll
        for (int q = 0; q < 4; ++q) { f32x16 pq = qk_tile32((q < 2 ? KT0 : KT1) + (q & 1) * 32 * KTP, KTP, qf, r, h);
#pragma unroll
            for (int reg = 0; reg < 16; ++reg) { const int n = 32 * q + 4 * h + (reg & 3) + 8 * (reg >> 2); pq[reg] = (n <= hin) ? fexp2((pq[reg] - mx) * LOG2E) : 0.f; sum += pq[reg]; }
#pragma unroll
            for (int gq = 0; gq < 4; ++gq) { SC[r * 33 + 8 * q + 2 * gq + h] = (pq[4 * gq] + pq[4 * gq + 1]) + (pq[4 * gq + 2] + pq[4 * gq + 3]); edge[4 * q + gq] = pq[4 * gq + 3]; }
            pv_tile32(o0, o1, (q < 2 ? VT0 : VT1) + (q & 1) * 32 * VTP, VTP, pq, lane);
            __builtin_amdgcn_sched_barrier(0); }
        sum += __shfl_xor(sum, 32);
        const float inv = sum > 0.f ? 1.f / sum : 0.f;
        __syncthreads();
#pragma unroll
        for (int q = 0; q < 4; ++q)
#pragma unroll
            for (int gq = 0; gq < 4; ++gq) SC[r * 33 + 8 * q + 2 * gq + h + 1] += edge[4 * q + gq];
        if (h == 0) SC[32 * 33 + r] = inv;
        const float g0 = sigmoidf_(gx0) * inv;
        out0 = o0 * g0; out1 = o1 * g0;
        __syncthreads();
#ifndef CUT_SEL
        selmask = select_blocks_wave(SC, SCI, lane, 64 * c + 8 * w, c, false);
#else
        selmask = SC[lane];
#endif
    }
    LAS float* OUTW = (LAS float*)(F.lds + 36864) + w * 2048 + lane;
    __syncthreads();
#pragma unroll
    for (int i = 0; i < 16; ++i) { OUTW[i * 64] = out0[i]; OUTW[(16 + i) * 64] = out1[i]; }
#pragma unroll
    for (int s = 0; s < 4; ++s) qf[s] = *(const bf16x8*)(F.NQ + row * 1024 + head * 64 + 16 * s + 8 * h);
#ifndef CUT_SLC
    {
        AState st; astate_init(st);
        int tid2 = tid; asm volatile("" : "+v"(tid2));
        const bf16* kb = F.KB16 + ((size_t)(0 * NB * 4 + b * 4 + kv) * TT) * 64; const bf16* vb = F.VT16 + ((size_t)(0 * NB * 4 + b * 4 + kv) * TT) * 64;
        StageRegs g0 = stage_load(kb, vb, tid2), g1 = g0;
        if (c >= 1) g1 = stage_load(kb + (size_t)64 * 64, vb + (size_t)64 * 64, tid2);
#pragma unroll 1
        for (int j = 0; j <= c; j += 2) {
            const bool two = (j + 1 <= c);
            __syncthreads();
            stage_store(KT0, VT0, g0, tid2); if (two) stage_store(KT1, VT1, g1, tid2);
            __syncthreads();
            if (j + 2 <= c) g0 = stage_load(kb + (size_t)(j + 2) * 64 * 64, vb + (size_t)(j + 2) * 64 * 64, tid2);
            if (j + 3 <= c) g1 = stage_load(kb + (size_t)(j + 3) * 64 * 64, vb + (size_t)(j + 3) * 64 * 64, tid2);
            { const bool fl = (selmask >> j) & 1u;
              tile_online(st, KT0, KTP, VT0, VTP, qf, 64 * j, 0, qpos, fl, r, h);
              tile_online(st, KT0 + 32 * KTP, KTP, VT0 + 32 * VTP, VTP, qf, 64 * j + 32, 0, qpos, fl, r, h);
              __builtin_amdgcn_sched_barrier(0); }
            if (two) { const bool fl = (selmask >> (j + 1)) & 1u;
              tile_online(st, KT1, KTP, VT1, VTP, qf, 64 * j + 64, 0, qpos, fl, r, h);
              tile_online(st, KT1 + 32 * KTP, KTP, VT1 + 32 * VTP, VTP, qf, 64 * j + 96, 0, qpos, fl, r, h);
              __builtin_amdgcn_sched_barrier(0); }
        }
        int l2 = lane; asm volatile("" : "+v"(l2));
        const int r2 = l2 & 31; const size_t row2 = (size_t)b * TT + 64 * c + 8 * w + (r2 >> 2);
        const float sc = sigmoidf_(gx1) * (st.l > 0.f ? 1.f / st.l : 0.f);
#pragma unroll
        for (int i = 0; i < 16; ++i) { OUTW[i * 64] += st.o0[i] * sc; OUTW[(16 + i) * 64] += st.o1[i] * sc; }
    }
#endif
#ifndef CUT_WIN
    {
        AState st; astate_init(st);
        const int jlo = c >= 8 ? c - 8 : 0;
        int tid3 = tid; asm volatile("" : "+v"(tid3));
        const bf16* kb = F.KB16 + ((size_t)(1 * NB * 4 + b * 4 + kv) * TT) * 64; const bf16* vb = F.VT16 + ((size_t)(1 * NB * 4 + b * 4 + kv) * TT) * 64;
        StageRegs g0 = stage_load(kb + (size_t)jlo * 64 * 64, vb + (size_t)jlo * 64 * 64, tid3), g1 = g0;
        if (jlo + 1 <= c) g1 = stage_load(kb + (size_t)(jlo + 1) * 64 * 64, vb + (size_t)(jlo + 1) * 64 * 64, tid3);
#pragma unroll 1
        for (int j = jlo; j <= c; j += 2) {
            const bool two = (j + 1 <= c);
            __syncthreads();
            stage_store(KT0, VT0, g0, tid3); if (two) stage_store(KT1, VT1, g1, tid3);
            __syncthreads();
            if (j + 2 <= c) g0 = stage_load(kb + (size_t)(j + 2) * 64 * 64, vb + (size_t)(j + 2) * 64 * 64, tid3);
            if (j + 3 <= c) g1 = stage_load(kb + (size_t)(j + 3) * 64 * 64, vb + (size_t)(j + 3) * 64 * 64, tid3);
            tile_online(st, KT0, KTP, VT0, VTP, qf, 64 * j, qpos - 511, qpos, true, r, h);
            tile_online(st, KT0 + 32 * KTP, KTP, VT0 + 32 * VTP, VTP, qf, 64 * j + 32, qpos - 511, qpos, true, r, h);
            if (two) {
              tile_online(st, KT1, KTP, VT1, VTP, qf, 64 * j + 64, qpos - 511, qpos, true, r, h);
              tile_online(st, KT1 + 32 * KTP, KTP, VT1 + 32 * VTP, VTP, qf, 64 * j + 96, qpos - 511, qpos, true, r, h);
              __builtin_amdgcn_sched_barrier(0); }
        }
        int l2 = lane; asm volatile("" : "+v"(l2));
        const int r2 = l2 & 31; const size_t row2 = (size_t)b * TT + 64 * c + 8 * w + (r2 >> 2);
        const float sc = sigmoidf_(gx2) * (st.l > 0.f ? 1.f / st.l : 0.f);
#pragma unroll
        for (int i = 0; i < 16; ++i) { out0[i] = OUTW[i * 64] + st.o0[i] * sc; out1[i] = OUTW[(16 + i) * 64] + st.o1[i] * sc; }
    }
#endif
    int l3 = lane; asm volatile("" : "+v"(l3));
    const int r3 = l3 & 31, h3 = l3 >> 5; const size_t row3 = (size_t)b * TT + 64 * c + 8 * w + (r3 >> 2);
    bf16* mp = F.MIX + row3 * DM + 1024 + (kv * 4 + (r3 & 3)) * 64;
#pragma unroll
    for (int gq = 0; gq < 4; ++gq) {
        u32x2 a; a.x = pk2(out0[4 * gq], out0[4 * gq + 1]); a.y = pk2(out0[4 * gq + 2], out0[4 * gq + 3]); *(u32x2*)(mp + 8 * gq + 4 * h3) = a;
        u32x2 bq; bq.x = pk2(out1[4 * gq], out1[4 * gq + 1]); bq.y = pk2(out1[4 * gq + 2], out1[4 * gq + 3]); *(u32x2*)(mp + 32 + 8 * gq + 4 * h3) = bq;
    }
    __syncthreads();
}

constexpr int SKP = 72, SVP = 72;
struct SampRegs { f32x4 kx[8], vx[8]; unsigned ok; };
template <class RowPtr>
DI void sample_issue(SampRegs& R, const RowPtr& rp, const float* dummy, int tid_in) {
    int tid = tid_in; asm volatile("" : "+v"(tid));
    const int krow = tid >> 4, piece = tid & 15;
    R.ok = 0u;
#pragma unroll
    for (int p = 0; p < 8; ++p) { const float* sp = rp(32 * p + krow); R.ok |= (sp ? 1u : 0u) << p; const float* a = (sp ? sp : dummy) + 4 * piece;
        R.kx[p] = __builtin_nontemporal_load((const f32x4*)a); R.vx[p] = __builtin_nontemporal_load((const f32x4*)(a + 256)); }
}
DI void sample_commit(LAS bf16* KT, LAS bf16* VT, const SampRegs& R, int tid_in) {
    int tid = tid_in; asm volatile("" : "+v"(tid));
    const int krow = tid >> 4, piece = tid & 15;
#pragma unroll
    for (int p = 0; p < 8; ++p) { const int key = 32 * p + krow; const bool ok = (R.ok >> p) & 1u; const f32x4 a = ok ? R.kx[p] : (f32x4){0.f, 0.f, 0.f, 0.f}, b = ok ? R.vx[p] : (f32x4){0.f, 0.f, 0.f, 0.f};
        *(LAS u32x2*)(KT + key * SKP + 4 * piece) = (u32x2){pk2(a[0], a[1]), pk2(a[2], a[3])};
        *(LAS u32x2*)(VT + key * SVP + 4 * piece) = (u32x2){pk2(b[0], b[1]), pk2(b[2], b[3])}; }
}
struct SlcRows { const float* c_slc; const float* newrows; const LAS int* ptab; unsigned uni; int db, kv, sb;
    DI const float* operator()(int key) const {
        if (sb < 8) { const int j = 4 * sb + (key >> 6); if (!((uni >> j) & 1u)) return nullptr; const int page = ptab[j >> 1];
            return c_slc + ((size_t)page * 128 + (j & 1) * 64 + (key & 63)) * 512 + kv * 64; }
        return key < 8 ? newrows + ((size_t)db * 8 + key) * 512 + kv * 64 : nullptr; } };
struct WinRows { const float* c_win; const float* newrows; int db, kv, sb;
    DI const float* operator()(int key) const {
        if (sb < 2) return c_win + ((size_t)db * 512 + 256 * sb + key) * 512 + kv * 64;
        return key < 8 ? newrows + ((size_t)db * 512 + 504 + key) * 512 + kv * 64 : nullptr; } };
DI void sample_merge(Frame& F, LAS float* XM, LAS float* XL, const float mw, const float lw, const f32x16& o0, const f32x16& o1, float gate, f32x4& fin, int w, int r, int h) {
    LAS float* RED = (LAS float*)F.lds;
    __syncthreads();
    if (h == 0) { XM[w * 32 + r] = mw; XL[w * 32 + r] = lw; }
    __syncthreads();
    float m = -1e30f;
#pragma unroll
    for (int i = 0; i < 8; ++i) m = fmaxf(m, XM[i * 32 + r]);
    float l = 0.f;
#pragma unroll
    for (int i = 0; i < 8; ++i) l += XL[i * 32 + r] * fexp2((XM[i * 32 + r] - m) * LOG2E);
    const float f = (l > 0.f) ? gate * fexp2((mw - m) * LOG2E) / l : 0.f;
#pragma unroll
    for (int reg = 0; reg < 16; ++reg) { const int d = (reg & 3) + 8 * (reg >> 2) + 4 * h; RED[(w * 32 + r) * 64 + d] = o0[reg] * f; RED[(w * 32 + r) * 64 + 32 + d] = o1[reg] * f; }
    __syncthreads();
    { const int q = F.tid >> 4, d4 = (F.tid & 15) * 4;
#pragma unroll
      for (int i = 0; i < 8; ++i) fin = fin + *(const LAS f32x4*)(RED + (i * 32 + q) * 64 + d4); }
    __syncthreads();
}
DI void nsa_sample_unit(Frame& F, int db, int kv) {
    LAS bf16* KT = (LAS bf16*)(F.lds), *VT = (LAS bf16*)(F.lds + 36864);
    LAS float *SC = (LAS float*)(F.lds + 73728), *SCI = (LAS float*)(F.lds + 78208), *XM = (LAS float*)(F.lds + 79264), *XL = (LAS float*)(F.lds + 80288);
    LAS unsigned* SMASK = (LAS unsigned*)(F.lds + 81312); LAS int* PT = (LAS int*)(F.lds + 81408);
    int tid_ = F.tid; asm volatile("" : "+v"(tid_));
    const int tid = tid_, lane = tid & 63, w = F.wave, r = lane & 31, h = lane >> 5;
    const int ts = r >> 2, g = r & 3, head = kv * 4 + g, qpos = TT + ts;
    const size_t row = (size_t)MP + db * 8 + ts;
    bf16x8 qf[4];
#pragma unroll
    for (int s = 0; s < 4; ++s) qf[s] = *(const bf16x8*)(F.NQ + row * 1024 + head * 64 + 16 * s + 8 * h);
    const float* gp = F.EXTRA + row * 64 + 16 + head * 3;
    const float g0 = sigmoidf_(gp[0]), g1 = sigmoidf_(gp[1]), g2 = sigmoidf_(gp[2]);
    f32x4 fin = {0.f, 0.f, 0.f, 0.f};
    __syncthreads();
    if (tid < 16) PT[tid] = F.ptab[db * 16 + tid];
    {
        const bf16* kc = F.KC16 + ((size_t)db * 4 + kv) * 128 * 64; const bf16* vc = F.VCT16 + ((size_t)db * 4 + kv) * 128 * 64;
#pragma unroll
        for (int q = 0; q < 2; ++q) { const int e = tid + 512 * q;
            *(LAS u32x4*)(KT + (e >> 3) * SKP + (e & 7) * 8) = *(const u32x4*)(kc + e * 8); *(LAS u32x4*)(VT + (e >> 3) * SVP + (e & 7) * 8) = *(const u32x4*)(vc + e * 8); }
        __syncthreads();
        f32x16 p = zero16(); float mw = -1e30f, lw = 0.f;
        if (w < 4) {
            p = qk_tile32(KT + 32 * w * SKP, SKP, qf, r, h);
#pragma unroll
            for (int reg = 0; reg < 16; ++reg) { const int n = 32 * w + 4 * h + (reg & 3) + 8 * (reg >> 2); p[reg] = (n <= 126) ? p[reg] : -1e30f; mw = fmaxf(mw, p[reg]); }
            mw = fmaxf(mw, __shfl_xor(mw, 32));
#pragma unroll
            for (int reg = 0; reg < 16; ++reg) { p[reg] = (p[reg] > -1e29f) ? fexp2((p[reg] - mw) * LOG2E) : 0.f; lw += p[reg]; }
            lw += __shfl_xor(lw, 32);
        }
        if (h == 0) { XM[w * 32 + r] = mw; XL[w * 32 + r] = lw; }
        __syncthreads();
        float m = -1e30f;
#pragma unroll
        for (int i = 0; i < 8; ++i) m = fmaxf(m, XM[i * 32 + r]);
        float l = 0.f;
#pragma unroll
        for (int i = 0; i < 8; ++i) l += XL[i * 32 + r] * fexp2((XM[i * 32 + r] - m) * LOG2E);
        const float f = (l > 0.f) ? fexp2((mw - m) * LOG2E) / l : 0.f;
        p = p * f;
        if (w < 4) {
#pragma unroll
            for (int gq = 0; gq < 4; ++gq) SC[r * 33 + 8 * w + 2 * gq + h] = (p[4 * gq] + p[4 * gq + 1]) + (p[4 * gq + 2] + p[4 * gq + 3]);
        }
        if (w == 4 && h == 0) SC[32 * 33 + r] = 1.f;
        __syncthreads();
        f32x16 o0 = zero16(), o1 = zero16();
        if (w < 4) {
#pragma unroll
            for (int gq = 0; gq < 4; ++gq) SC[r * 33 + 8 * w + 2 * gq + h + 1] += p[4 * gq + 3];
            pv_tile32(o0, o1, VT + 32 * w * SVP, SVP, p, lane);
        }
        __syncthreads();
        unsigned bits = select_blocks_wave(SC, SCI, lane, TT, 32, true);
        if (w == 0 && lane < 32 && (lane & 3) == 0) SMASK[lane >> 2] = bits;
        sample_merge(F, XM, XL, 0.f, (w == 0) ? 1.f : 0.f, o0, o1, g0, fin, w, r, h);
    }
    const unsigned selmask = SMASK[ts];
    unsigned uni = 0u;
#pragma unroll
    for (int i = 0; i < 8; ++i) uni |= SMASK[i];
    {
        AState st; astate_init(st);
        SampRegs R;
        { const SlcRows rp{F.c_slc, F.out + O_SLCS, PT, uni, db, kv, 0}; sample_issue(R, rp, F.c_win, tid); }
#pragma unroll 1
        for (int sb = 0; sb < 9; ++sb) {
            __syncthreads();
            sample_commit(KT, VT, R, tid);
            __syncthreads();
            if (sb + 1 < 9) { const SlcRows rp{F.c_slc, F.out + O_SLCS, PT, uni, db, kv, sb + 1}; sample_issue(R, rp, F.c_win, tid); }
            const int j = 4 * sb + (w >> 1);
            const bool fl = (j >= 32) ? true : ((selmask >> j) & 1u);
            tile_online(st, KT + 32 * w * SKP, SKP, VT + 32 * w * SVP, SVP, qf, 256 * sb + 32 * w, 0, qpos, fl, r, h);
        }
        sample_merge(F, XM, XL, st.m, st.l, st.o0, st.o1, g1, fin, w, r, h);
    }
    {
        AState st; astate_init(st);
        SampRegs R;
        { const WinRows rp{F.c_win, F.out + O_WINS, db, kv, 0}; sample_issue(R, rp, F.c_win, tid); }
#pragma unroll 1
        for (int sb = 0; sb < 3; ++sb) {
            __syncthreads();
            sample_commit(KT, VT, R, tid);
            __syncthreads();
            if (sb + 1 < 3) { const WinRows rp{F.c_win, F.out + O_WINS, db, kv, sb + 1}; sample_issue(R, rp, F.c_win, tid); }
            tile_online(st, KT + 32 * w * SKP, SKP, VT + 32 * w * SVP, SVP, qf, (TT - 512) + 256 * sb + 32 * w, qpos - 511, qpos, true, r, h);
        }
        sample_merge(F, XM, XL, st.m, st.l, st.o0, st.o1, g2, fin, w, r, h);
    }
    { const int q = tid >> 4, d4 = (tid & 15) * 4;
      u32x2 wv; wv.x = pk2(fin[0], fin[1]); wv.y = pk2(fin[2], fin[3]);
      *(u32x2*)(F.MIX + ((size_t)MP + db * 8 + (q >> 2)) * DM + 1024 + (kv * 4 + (q & 3)) * 64 + d4) = wv; }
    __syncthreads();
}

#ifndef MK_ONE_LAUNCH
#define MK_ONE_LAUNCH 1
#endif
constexpr int NPHASE = 13;
#ifndef GEMM_SP2
#define GEMM_SP2 true
#endif
#ifndef GEMM_ALIGN
#define GEMM_ALIGN true
#endif
struct Args { const void* in[21]; float* out; unsigned char* ws; int ph_lo, ph_hi; };
static_assert(sizeof(Args) == 21 * 8 + 8 + 8 + 8, "Args has no padding");

__global__ void __launch_bounds__(NWAVES * 64, 2) hybrid_fwd(Args args) {
    extern __shared__ __attribute__((aligned(16))) unsigned char lds[];
    Frame F;
    F.lds = (LAS unsigned char*)lds;
    F.MISC = (volatile LAS unsigned*)(F.lds + MISC_OFF);
    F.tid = threadIdx.x; F.lane = F.tid & 63; F.wave = __builtin_amdgcn_readfirstlane(F.tid >> 6);
    F.G = gridDim.x; { const int bx = blockIdx.x; F.vcu = (F.G % 8 == 0) ? (bx % 8) * (F.G / 8) + bx / 8 : bx; }
    unsigned char* ws = args.ws;
    F.ctl = (gu32*)(ws + WS_CTL);
    F.out = args.out;
    F.x_p = (const float*)args.in[0]; F.x_s = (const float*)args.in[1]; F.c_cmp = (const float*)args.in[2]; F.c_slc = (const float*)args.in[3]; F.c_win = (const float*)args.in[4];
    F.st_gla = (const float*)args.in[5]; F.ptab = (const int*)args.in[6]; F.w1a = (const float*)args.in[7]; F.w1b = (const float*)args.in[8]; F.w_in = (const float*)args.in[9];
    F.w_g2 = (const float*)args.in[10]; F.b_g2 = (const float*)args.in[11]; F.gnorm = (const float*)args.in[12]; F.cpos = (const float*)args.in[13]; F.cw1 = (const float*)args.in[14];
    F.cw2 = (const float*)args.in[15]; F.w_out = (const float*)args.in[16]; F.w2a = (const float*)args.in[17]; F.w2b = (const float*)args.in[18]; F.ln_g = (const float*)args.in[19]; F.ln_b = (const float*)args.in[20];
    F.CBIAS = (float*)(ws + WS_SMALL);
    F.W1A = (bf16*)(ws + WS_W1A); F.W1B = (bf16*)(ws + WS_W1B); F.WIN = (bf16*)(ws + WS_WIN); F.WOUT = (bf16*)(ws + WS_WOUT); F.W2A = (bf16*)(ws + WS_W2A); F.W2B = (bf16*)(ws + WS_W2B);
    F.CW1 = (bf16*)(ws + WS_CW1); F.XB = (bf16*)(ws + WS_XB); F.HB = (bf16*)(ws + WS_HB); F.ZF = (float*)(ws + WS_ZF); F.G16 = (bf16*)(ws + WS_GLAIN); F.NQ = (bf16*)(ws + WS_NQ);
    F.EXTRA = (float*)(ws + WS_EXTRA); F.WINROWS = (float*)(ws + WS_WINROWS); F.ORAW = (float*)(ws + WS_ORAW); F.MIX = (bf16*)(ws + WS_MIX); F.XBLK = (bf16*)(ws + WS_XBLK);
    F.ZC = (float*)(ws + WS_ZC); F.KCMP = (float*)(ws + WS_KCMP);
    F.GQ = (bf16*)(ws + WS_GQ); F.GKT = (bf16*)(ws + WS_GKT); F.GA = (bf16*)(ws + WS_GA); F.GVT = (bf16*)(ws + WS_GVT); F.GD = (float*)(ws + WS_GD); F.SLAB = (float*)(ws + WS_SLAB);
    F.KB16 = (bf16*)(ws + WS_KB16); F.VT16 = (bf16*)(ws + WS_VT16); F.KC16 = (bf16*)(ws + WS_KC16); F.VCT16 = (bf16*)(ws + WS_VCT16);
    for (int u = F.tid; u < (LDS_BYTES - LDSCTL_OFF) / 4; u += NWAVES * 64) ((LAS unsigned*)(F.lds + LDSCTL_OFF))[u] = 0u;
    __syncthreads();
    const int lo = args.ph_lo, hi = args.ph_hi;
    XcdBarrier bar; bar.bar = (unsigned*)(F.ctl + CW_BAR); bar.x = 0; bar.st = nullptr;
    if (hi - lo > 1) bar = xcd_barrier_post((unsigned*)(F.ctl + CW_BAR), F.MISC + 8);
#ifndef PH_MASK
#define PH_MASK 0xFFFF
#endif
#define IN(k) (((PH_MASK >> (k)) & 1) && lo <= (k) && (k) < hi)
#define PH_BEGIN() do { int t_ = threadIdx.x; asm volatile("" : "+v"(t_)); F.tid = t_; F.lane = t_ & 63; F.wave = __builtin_amdgcn_readfirstlane(t_ >> 6); } while (0)
#define SEAM(k) do { if (IN(k) && IN((k) + 1)) xcd_barrier(bar); } while (0)
    const int bx = (int)blockIdx.x;

    if (IN(0)) { PH_BEGIN(); p0_prologue(F); } SEAM(0);
    if (IN(1)) { PH_BEGIN(); pg8::Gemm g{F.XB, F.W1A, MTOT, 2 * DFF, DM}; pg8::StaticOrder S; S.init(MTOT, 2 * DFF, F.G, bx); EpiSwiGLU E{F.HB};
        if (F.vcu & 1) { xblk_part(F, F.vcu, F.G); __syncthreads(); }
        pg8::gemm_phase<EpiSwiGLU, pg8::StaticOrder, GEMM_ALIGN, GEMM_SP2>(F.lds, g, S, E);
        if (!(F.vcu & 1)) { __syncthreads(); xblk_part(F, F.vcu, F.G); }
        late_tail(F, 1, bx, (MTOT / 256) * (2 * DFF / 256));
 } SEAM(1);
#ifndef REP_FFO
#define REP_FFO 1
#endif
#ifdef EXP_HOTA
    if (IN(2)) { struct HotOrder : pg8::StaticOrder { DI bool next(int i, pg8::Unit& u) const { const bool r = pg8::StaticOrder::next(i, u); u.pm = u.pm & 7; return r; } };
        pg8::Gemm g{F.HB, F.W1B, MP, DM, DFF, 0}; HotOrder S; S.init(MP, DM, F.G, bx); EpiResid E{F.x_p, (bf16*)F.ORAW, 0.5f};
        pg8::gemm_phase<EpiResid, HotOrder, true, GEMM_SP2>(F.lds, g, S, E); }
#endif
    if (IN(2)) { PH_BEGIN(); for (int rep = 0; rep < REP_FFO; ++rep) { pg8::Gemm g{F.HB, F.W1B, MP, DM, DFF, 0}; pg8::StaticOrder S; S.init(MP, DM, F.G, bx); EpiResid E{F.x_p, (bf16*)F.ZF, 0.5f};
          pg8::gemm_phase<EpiResid, pg8::StaticOrder, GEMM_ALIGN, GEMM_SP2>(F.lds, g, S, E); }
        { pg8::Gemm g{F.HB, F.W1B, MTOT, DM, DFF / NSPLIT, DFF}; SplitOrder S{F.G, bx, (DFF / NSPLIT) * 2}; EpiSlab E{F.SLAB, (DFF / NSPLIT) * 2};
          pg8::gemm_phase<EpiSlab, SplitOrder, GEMM_ALIGN, GEMM_SP2>(F.lds, g, S, E); }
        late_tail(F, 2, bx, 32 * NSPLIT); } SEAM(2);
    if (IN(3)) { PH_BEGIN(); ln_phase(F, (const bf16*)F.ZF, nullptr, F.XB, F.ln_g, F.ln_b, F.x_s, nullptr, 0.5f); } SEAM(3);
    if (IN(4)) { PH_BEGIN(); pg8::Gemm g{F.XB, F.WIN, MTOT, NIN, DM}; pg8::StaticOrder S; S.init(MTOT, NIN, F.G, bx); EpiInProj E{F.G16, F.NQ, F.out, F.WINROWS, F.XBLK, F.KB16, F.VT16};
#ifndef REP_EXTRA
#define REP_EXTRA 1
#endif
        if (F.vcu & 1) { for (int rep = 0; rep < REP_EXTRA; ++rep) extra_phase(F, F.G - 1 - bx, F.G); __syncthreads(); }
        pg8::gemm_phase<EpiInProj, pg8::StaticOrder, GEMM_ALIGN, GEMM_SP2>(F.lds, g, S, E);
        if (!(F.vcu & 1)) { __syncthreads(); for (int rep = 0; rep < REP_EXTRA; ++rep) extra_phase(F, F.G - 1 - bx, F.G); }
        late_tail(F, 4, bx, (MTOT / 256) * (NIN / 256)); } SEAM(4);
    if (IN(5)) { PH_BEGIN();
#ifndef REP_GPRE
#define REP_GPRE 1
#endif
#ifndef REP_GSMP
#define REP_GSMP 1
#endif
#ifndef REP_CGEMM
#define REP_CGEMM 1
#endif
#ifndef REP_GSEQ
#define REP_GSEQ 1
#endif
#ifndef REP_ZC
#define REP_ZC 1
#endif
        const bool gemm_first = (F.vcu & 1) != 0;
        if (gemm_first) { __syncthreads();
            for (int rep = 0; rep < REP_CGEMM; ++rep) { pg8::Gemm g{F.XBLK, F.CW1, 2 * XROWS, 512, 1024}; CmpOrder S{F.G, bx}; EpiZ E{(bf16*)F.ZC};
              pg8::gemm_phase<EpiZ, CmpOrder, GEMM_ALIGN, GEMM_SP2>(F.lds, g, S, E); }
            __syncthreads(); }
        for (int rep = 0; rep < REP_GPRE; ++rep) { PreRegs PR; if (F.vcu < NB * 4 * 32) { pre_load_qk(F, PR, F.vcu, F.tid); pre_load_v(F, PR, F.vcu, F.tid); }
            for (int it = F.vcu; it < NB * 4 * 32; it += F.G) gla_pre_item(F, it, PR, it + F.G < NB * 4 * 32 ? it + F.G : -1); }
        for (int rep = 0; rep < REP_GSMP; ++rep) for (int u = F.vcu; u < NDB * 4; u += F.G) gla_sample_unit(F, u >> 2, u & 3);
        __syncthreads();
        if (!gemm_first) {
            for (int rep = 0; rep < REP_CGEMM; ++rep) { pg8::Gemm g{F.XBLK, F.CW1, 2 * XROWS, 512, 1024}; CmpOrder S{F.G, bx}; EpiZ E{(bf16*)F.ZC};
              pg8::gemm_phase<EpiZ, CmpOrder, GEMM_ALIGN, GEMM_SP2>(F.lds, g, S, E); }
            __syncthreads(); }
        late_tail(F, 5, bx, 2 * (XROWS / 256));
    } SEAM(5);
    if (IN(6)) { PH_BEGIN();
        const int nseq = NB * 4 * 4;
        if (F.G == 2 * nseq) { const int u = F.vcu >> 1;
                               if ((F.vcu & 1) == 0) { for (int rep = 0; rep < REP_GSEQ; ++rep) gla_seq_unit(F, u >> 4, (u >> 2) & 3, u & 3); }
                               else { for (int rep = 0; rep < REP_ZC; ++rep) zcombine_phase(F, u, nseq); } }
        else { for (int u = F.vcu; u < nseq; u += F.G) gla_seq_unit(F, u >> 4, (u >> 2) & 3, u & 3); zcombine_phase(F, F.vcu, F.G); } } SEAM(6);
#ifdef EXP_BARS
    if (IN(6) && IN(7)) { for (int q = 0; q < 8; ++q) xcd_barrier(bar); }
#endif
    if (IN(7)) { PH_BEGIN();
#ifndef REP_NSAP
#define REP_NSAP 1
#endif
#ifndef REP_NSAS
#define REP_NSAS 1
#endif
#pragma unroll 1
        for (int half = 0; half < 2; ++half) {
            if ((half ^ (F.vcu & 1)) == 0) {
                for (int rep = 0; rep < REP_NSAP; ++rep)
                for (int U = F.vcu; U < 1024; U += F.G) { const int i = U >> 8, id = U & 255, bk = id >> 3, q = id & 7; const int c = i == 0 ? q : (i == 1 ? 15 - q : (i == 2 ? 16 + q : 31 - q));
                    nsa_prompt_unit(F, bk >> 2, bk & 3, c); }
            } else {
                for (int rep = 0; rep < REP_NSAS; ++rep)
                for (int u = F.vcu; u < NDB * 4; u += F.G) nsa_sample_unit(F, u >> 2, u & 3);
            }
        }
#ifndef REP_FIN
#define REP_FIN 1
#endif
        for (int rep = 0; rep < REP_FIN; ++rep) gla_finalize_phase(F);
    } SEAM(7);
    if (IN(8)) { PH_BEGIN(); { pg8::Gemm g{F.MIX, F.WOUT, MP, DM, DM, 0}; pg8::StaticOrder S; S.init(MP, DM, F.G, bx); EpiResid16 E{F.XB, (bf16*)F.ZF, 1.0f};
          pg8::gemm_phase<EpiResid16, pg8::StaticOrder, GEMM_ALIGN, GEMM_SP2>(F.lds, g, S, E); }
        { pg8::Gemm g{F.MIX, F.WOUT, MTOT, DM, DM / NSPLIT, DM}; SplitOrder S{F.G, bx, (DM / NSPLIT) * 2}; EpiSlab E{F.SLAB, (DM / NSPLIT) * 2};
          pg8::gemm_phase<EpiSlab, SplitOrder, GEMM_ALIGN, GEMM_SP2>(F.lds, g, S, E); }
        late_tail(F, 8, bx, 32 * NSPLIT); } SEAM(8);
    if (IN(9)) { PH_BEGIN(); ln_phase(F, (const bf16*)F.ZF, nullptr, F.XB, F.ln_g + DM, F.ln_b + DM, nullptr, F.XB + (size_t)MP * DM, 1.0f); } SEAM(9);
    if (IN(10)) { PH_BEGIN(); pg8::Gemm g{F.XB, F.W2A, MTOT, 2 * DFF, DM}; pg8::StaticOrder S; S.init(MTOT, 2 * DFF, F.G, bx); EpiSwiGLU E{F.HB};
        pg8::gemm_phase<EpiSwiGLU, pg8::StaticOrder, GEMM_ALIGN, GEMM_SP2>(F.lds, g, S, E);
        late_tail(F, 10, bx, (MTOT / 256) * (2 * DFF / 256)); } SEAM(10);
    if (IN(11)) { PH_BEGIN(); { pg8::Gemm g{F.HB, F.W2B, MP, DM, DFF, 0}; pg8::StaticOrder S; S.init(MP, DM, F.G, bx); EpiResid16 E{F.XB, (bf16*)F.ZF, 0.5f};
          pg8::gemm_phase<EpiResid16, pg8::StaticOrder, GEMM_ALIGN, GEMM_SP2>(F.lds, g, S, E); }
        { pg8::Gemm g{F.HB, F.W2B, MTOT, DM, DFF / NSPLIT, DFF}; SplitOrder S{F.G, bx, (DFF / NSPLIT) * 2}; EpiSlab E{F.SLAB, (DFF / NSPLIT) * 2};
          pg8::gemm_phase<EpiSlab, SplitOrder, GEMM_ALIGN, GEMM_SP2>(F.lds, g, S, E); }
        late_tail(F, 11, bx, 32 * NSPLIT); } SEAM(11);
    if (IN(12)) { PH_BEGIN(); ln_phase(F, (const bf16*)F.ZF, F.out, nullptr, F.ln_g + 2 * DM, F.ln_b + 2 * DM, nullptr, F.XB + (size_t)MP * DM, 0.5f); }
#undef IN
#undef SEAM
}

extern "C" void kernel_launch(void* const* d_in, const int* in_sizes, int n_in, void* d_out, int out_size, void* d_ws, size_t ws_size, hipStream_t stream) {
    static int grid = 0;
    if (grid == 0) {
        if (n_in != 21 || out_size != (int)O_END || ws_size < WS_END) { fprintf(stderr, "kernel_launch: unexpected shapes: n_in %d out %d ws %zu (need %zu)\n", n_in, out_size, ws_size, (size_t)WS_END); grid = -1; return; }
        int dev = 0, cus = 0;
        if (hipGetDevice(&dev) != hipSuccess || hipDeviceGetAttribute(&cus, hipDeviceAttributeMultiprocessorCount, dev) != hipSuccess) { grid = -1; return; }
        if (hipFuncSetAttribute((const void*)hybrid_fwd, hipFuncAttributeMaxDynamicSharedMemorySize, LDS_BYTES) != hipSuccess) { fprintf(stderr, "kernel_launch: hipFuncSetAttribute failed\n"); grid = -1; return; }
        int per_cu = 0;
        if (hipOccupancyMaxActiveBlocksPerMultiprocessor(&per_cu, (const void*)hybrid_fwd, NWAVES * 64, LDS_BYTES) != hipSuccess || per_cu < 1) fprintf(stderr, "kernel_launch: occupancy query says %d\n", per_cu);
        (void)hipGetLastError();
        grid = cus;
    }
    if (grid < 0) return;
    (void)in_sizes;
    if (hipMemsetAsync((char*)d_ws + WS_CTL, 0, CTL_ZERO_BYTES, stream) != hipSuccess) return;
    Args a{};
    for (int i = 0; i < 21; ++i) a.in[i] = d_in[i];
    a.out = (float*)d_out; a.ws = (unsigned char*)d_ws;
#if MK_ONE_LAUNCH
    a.ph_lo = 0; a.ph_hi = NPHASE;
    hipLaunchKernelGGL(hybrid_fwd, dim3(grid), dim3(NWAVES * 64), LDS_BYTES, stream, a);
#else
#ifndef PROBE_DBL
#define PROBE_DBL 0
#endif
    for (int p = 0; p < NPHASE; ++p) { a.ph_lo = p; a.ph_hi = p + 1;
        for (int rep = 0; rep < 1 + ((PROBE_DBL >> p) & 1); ++rep) hipLaunchKernelGGL(hybrid_fwd, dim3(grid), dim3(NWAVES * 64), LDS_BYTES, stream, a); }
#endif
}
```

```cpp
#include <hip/hip_runtime.h>
#include <cstdio>
#include <cstdint>
namespace pg8 {
#define PG8_LAS __attribute__((address_space(3)))
typedef unsigned short bf16_t;
typedef short bf16x8 __attribute__((ext_vector_type(8)));
typedef float f32x4 __attribute__((ext_vector_type(4)));
typedef unsigned u32x4 __attribute__((ext_vector_type(4)));
constexpr int BM = 256, BK = 64, HALF = 128, HTB = HALF * BK * 2  , STAGE_BYTES = 8 * HTB, NXCD = 8, WGM = 8;

__host__ __device__ __forceinline__ int lds_byte(int r, int c) { const int st = (r >> 4) * 2 + (c >> 5), rr = r & 15, cc = c & 31, ob = rr * 64 + cc * 2; return st * 1024 + (ob ^ (((ob >> 9) & 1) << 5)); }
__host__ __device__ __forceinline__ void stage_rc(int b, int& R, int& C) { const int st = b / 1024, sb = b % 1024, swz = sb ^ (((sb >> 9) & 1) << 5); R = (st >> 1) * 16 + swz / 64; C = (st & 1) * 32 + (swz % 64) / 2; }
__host__ __device__ __forceinline__ int perm32(int rho) { const int n = rho >> 4, i = rho & 15; return 8 * (i >> 2) + 4 * n + (i & 3); }

struct Unit { int pm, pn, kb; };
struct Gemm { const bf16_t* A; const bf16_t* Bt; int M, N, K, ld; };

struct StaticOrder {
    int nM, nN, nwg, G, c;
    __host__ __device__ void init(int M, int N, int G_, int c_) { nM = M / BM; nN = N / BM; nwg = nM * nN; G = G_; c = c_; }
    __host__ __device__ bool next(int i, Unit& u) const {
        const long L = (long)i * G + c; if (L >= nwg) return false;
        int wgid = (int)L; { const int q = nwg / NXCD, r = nwg % NXCD, xcd = wgid % NXCD, off = wgid / NXCD; wgid = (xcd < r ? xcd * (q + 1) : r * (q + 1) + (xcd - r) * q) + off; }
        const int nig = WGM * nN, gid = wgid / nig, fm = gid * WGM, gsz = (nM - fm) < WGM ? (nM - fm) : WGM;
        u.pm = fm + ((wgid % nig) % gsz); u.pn = (wgid % nig) / gsz; u.kb = 0; return true;
    }
    __device__ __forceinline__ void a_ready(const Unit&) const {}
    __device__ __forceinline__ void done(const Unit&) const {}
};
template <class Epi, class Sched, bool ALIGN_EPI = false, bool SP2 = false>
__device__ __forceinline__ void gemm_phase(PG8_LAS unsigned char* lds, const Gemm g, const Sched& S, const Epi& E) {
    int tid_ = threadIdx.x; asm volatile("" : "+v"(tid_));
    const int tid = tid_, wid = __builtin_amdgcn_readfirstlane(tid >> 6), lane = tid & 63, wr = wid >> 2, wc = wid & 3, fr = lane & 15, fq = lane >> 4;
    const int K = g.K, nt = K / BK, LD = g.ld ? g.ld : g.K;
    unsigned voffA[2], voffB[2];
#pragma unroll
    for (int i = 0; i < 2; ++i) { int R, C; stage_rc(tid * 16 + i * 8192, R, C); const int Rb = Epi::PERM ? ((R & ~31) + perm32(R & 31)) : R;
        voffA[i] = (unsigned)(R * LD + C) * 2u; voffB[i] = (unsigned)(Rb * LD + C) * 2u; }
    const size_t kstep = (size_t)(BK * 2);
    const size_t hstep = (size_t)HALF * LD * 2;
    const size_t tstep = 2 * hstep;
    const unsigned ldsw = (unsigned)wid * 1024u;
    const int aoff = lds_byte(wr * 64 + fr, fq * 8), boff = lds_byte(wc * 32 + fr, fq * 8);
#define PG8_SA(b, h) (((b) * 2 + (h)) * HTB)
#define PG8_SB(b, h) ((4 + (b) * 2 + (h)) * HTB)
#define PG8_STAGE(bufoff, gbase, voff) do { _Pragma("unroll") for (int _i = 0; _i < 2; ++_i) \
        __builtin_amdgcn_global_load_lds((const unsigned*)((const char*)(gbase) + (voff)[_i]), (PG8_LAS unsigned*)(lds + (bufoff) + ldsw + _i * 8192), 16, 0, 0); } while (0)
#define PG8_LDA(dst, b, h) do { _Pragma("unroll") for (int m = 0; m < 4; ++m) _Pragma("unroll") for (int k = 0; k < 2; ++k) dst[m][k] = *(const PG8_LAS bf16x8*)(lds + PG8_SA(b, h) + aoff + m * 2048 + k * 1024); } while (0)
#define PG8_LDB(dst, b, h) do { _Pragma("unroll") for (int n = 0; n < 2; ++n) _Pragma("unroll") for (int k = 0; k < 2; ++k) dst[n][k] = *(const PG8_LAS bf16x8*)(lds + PG8_SB(b, h) + boff + n * 2048 + k * 1024); } while (0)
#define PG8_MMA(ai, bj, At, Bt) do { __builtin_amdgcn_s_setprio(1); _Pragma("unroll") for (int m = 0; m < 4; ++m) _Pragma("unroll") for (int n = 0; n < 2; ++n) _Pragma("unroll") for (int k = 0; k < 2; ++k) \
        acc[ai][bj][m][n] = __builtin_amdgcn_mfma_f32_16x16x32_bf16(Bt[n][k], At[m][k], acc[ai][bj][m][n], 0, 0, 0); __builtin_amdgcn_s_setprio(0); } while (0)
#define PG8_WAIT_V(n) asm volatile("s_waitcnt vmcnt(" #n ")" ::: "memory")
#define PG8_WAIT_L(n) asm volatile("s_waitcnt lgkmcnt(" #n ")" ::: "memory")
#define PG8_BAR __builtin_amdgcn_s_barrier()
#define PG8_SCHED __builtin_amdgcn_sched_barrier(0)
    Unit cur, nxt; int ui = 0;
    if (!S.next(0, cur)) return;
    f32x4 acc[2][2][4][2];
#pragma unroll
    for (int a = 0; a < 2; ++a)
#pragma unroll
        for (int b = 0; b < 2; ++b)
#pragma unroll
            for (int m = 0; m < 4; ++m)
#pragma unroll
                for (int n = 0; n < 2; ++n) acc[a][b][m][n] = (f32x4){0.f, 0.f, 0.f, 0.f};
    bf16x8 At[4][2], B0[2][2], B1[2][2];
    const char* cA = (const char*)g.A + (size_t)cur.pm * tstep + cur.kb; const char* cB = (const char*)g.Bt + (size_t)cur.pn * tstep + cur.kb;
    S.a_ready(cur);
    if constexpr (SP2) {
        PG8_STAGE(PG8_SB(0, 0), cB, voffB); PG8_STAGE(PG8_SB(0, 1), cB + hstep, voffB); PG8_STAGE(PG8_SA(0, 0), cA, voffA); PG8_STAGE(PG8_SA(0, 1), cA + hstep, voffA);
        if (wr == 1) PG8_BAR;
        PG8_WAIT_V(2); PG8_BAR;
        PG8_STAGE(PG8_SB(1, 0), cB + kstep, voffB); PG8_STAGE(PG8_SA(1, 0), cA + kstep, voffA); PG8_STAGE(PG8_SB(1, 1), cB + hstep + kstep, voffB);
        PG8_WAIT_V(6); PG8_BAR;
    } else {
        PG8_STAGE(PG8_SB(0, 0), cB, voffB); PG8_STAGE(PG8_SA(0, 0), cA, voffA); PG8_STAGE(PG8_SB(0, 1), cB + hstep, voffB); PG8_STAGE(PG8_SA(0, 1), cA + hstep, voffA);
        if (wr == 1) PG8_BAR;
        PG8_WAIT_V(4); PG8_BAR;
        PG8_STAGE(PG8_SB(1, 0), cB + kstep, voffB); PG8_STAGE(PG8_SA(1, 0), cA + kstep, voffA); PG8_STAGE(PG8_SB(1, 1), cB + hstep + kstep, voffB);
        PG8_WAIT_V(6); PG8_BAR;
    }
    for (;;) {
        const bool has_next = S.next(ui + 1, nxt);
        const char* nA = has_next ? (const char*)g.A + (size_t)nxt.pm * tstep + nxt.kb : cA; const char* nB = has_next ? (const char*)g.Bt + (size_t)nxt.pn * tstep + nxt.kb : cB;
        for (int t = 0; t < nt; t += 2) {
            const bool last = (t == nt - 2);
            const char* a1 = cA + (size_t)(t + 1) * kstep;
            const char* a2 = last ? nA : cA + (size_t)(t + 2) * kstep; const char* b2 = last ? nB : cB + (size_t)(t + 2) * kstep;
            const char* a3 = a2 + kstep; const char* b3 = b2 + kstep;
            if (last && has_next) S.a_ready(nxt);
            if constexpr (SP2) {
            PG8_LDB(B0, 0, 0); PG8_LDB(B1, 0, 1); PG8_SCHED; PG8_LDA(At, 0, 0); PG8_STAGE(PG8_SA(1, 1), a1 + hstep, voffA);
            PG8_WAIT_V(8); PG8_WAIT_L(0); PG8_BAR; PG8_MMA(0, 0, At, B0); PG8_MMA(0, 1, At, B1); PG8_BAR; PG8_SCHED;
            PG8_LDA(At, 0, 1); PG8_STAGE(PG8_SB(0, 0), b2, voffB); PG8_STAGE(PG8_SB(0, 1), b2 + hstep, voffB); PG8_STAGE(PG8_SA(0, 0), a2, voffA);
            PG8_WAIT_V(8); PG8_WAIT_L(0); PG8_BAR; PG8_MMA(1, 0, At, B0); PG8_MMA(1, 1, At, B1); PG8_BAR; PG8_SCHED;
            PG8_LDB(B0, 1, 0); PG8_LDB(B1, 1, 1); PG8_SCHED; PG8_LDA(At, 1, 0); PG8_STAGE(PG8_SA(0, 1), a2 + hstep, voffA);
            PG8_WAIT_V(8); PG8_WAIT_L(0); PG8_BAR; PG8_MMA(0, 0, At, B0); PG8_MMA(0, 1, At, B1); PG8_BAR; PG8_SCHED;
            PG8_LDA(At, 1, 1); PG8_STAGE(PG8_SB(1, 0), b3, voffB); PG8_STAGE(PG8_SB(1, 1), b3 + hstep, voffB); PG8_STAGE(PG8_SA(1, 0), a3, voffA);
            PG8_WAIT_V(8); PG8_WAIT_L(0); PG8_BAR; PG8_MMA(1, 0, At, B0); PG8_MMA(1, 1, At, B1); PG8_BAR; PG8_SCHED;
            } else {
            PG8_LDB(B0, 0, 0); PG8_SCHED; PG8_LDA(At, 0, 0); PG8_STAGE(PG8_SA(1, 1), a1 + hstep, voffA);
            PG8_WAIT_L(8); PG8_BAR; PG8_WAIT_L(0); PG8_MMA(0, 0, At, B0); PG8_BAR; PG8_SCHED;
            PG8_LDB(B1, 0, 1); PG8_STAGE(PG8_SB(0, 0), b2, voffB);
            PG8_BAR; PG8_WAIT_L(0); PG8_MMA(0, 1, At, B1); PG8_BAR;
            PG8_LDA(At, 0, 1); PG8_STAGE(PG8_SA(0, 0), a2, voffA);
            PG8_BAR; PG8_WAIT_L(0); PG8_MMA(1, 0, At, B0); PG8_BAR; PG8_SCHED;
            PG8_STAGE(PG8_SB(0, 1), b2 + hstep, voffB);
            PG8_WAIT_V(6); PG8_BAR; PG8_MMA(1, 1, At, B1); PG8_BAR;
            PG8_LDB(B0, 1, 0); PG8_SCHED; PG8_LDA(At, 1, 0); PG8_STAGE(PG8_SA(0, 1), a2 + hstep, voffA);
            PG8_WAIT_L(8); PG8_BAR; PG8_WAIT_L(0); PG8_MMA(0, 0, At, B0); PG8_BAR; PG8_SCHED;
            PG8_LDB(B1, 1, 1); PG8_STAGE(PG8_SB(1, 0), b3, voffB);
            PG8_BAR; PG8_WAIT_L(0); PG8_MMA(0, 1, At, B1); PG8_BAR;
            PG8_LDA(At, 1, 1); PG8_STAGE(PG8_SA(1, 0), a3, voffA);
            PG8_BAR; PG8_WAIT_L(0); PG8_MMA(1, 0, At, B0); PG8_BAR; PG8_SCHED;
            PG8_STAGE(PG8_SB(1, 1), b3 + hstep, voffB);
            PG8_WAIT_V(6); PG8_BAR; PG8_MMA(1, 1, At, B1); PG8_BAR;
            }
        }
        if constexpr (ALIGN_EPI) { if (wr == 0) PG8_BAR; }
        if constexpr (!Epi::AFTER_DRAIN) { E(acc, cur, wr, wc, fr, fq); S.done(cur); }
        if (!has_next) break;
#pragma unroll
        for (int a = 0; a < 2; ++a)
#pragma unroll
            for (int b = 0; b < 2; ++b)
#pragma unroll
                for (int m = 0; m < 4; ++m)
#pragma unroll
                    for (int n = 0; n < 2; ++n) acc[a][b][m][n] = (f32x4){0.f, 0.f, 0.f, 0.f};
        cur = nxt; cA = nA; cB = nB; ++ui;
        if constexpr (ALIGN_EPI) { if (wr == 1) PG8_BAR; }
    }
    PG8_WAIT_V(0);
    if constexpr (!ALIGN_EPI) { if (wr == 0) PG8_BAR; }
    PG8_BAR;
    if constexpr (Epi::AFTER_DRAIN) { E.fused(acc, cur, wr, wc, fr, fq, lds, wid, lane); S.done(cur); }
#undef PG8_SA
#undef PG8_SB
#undef PG8_STAGE
#undef PG8_LDA
#undef PG8_LDB
#undef PG8_MMA
#undef PG8_WAIT_V
#undef PG8_WAIT_L
#undef PG8_BAR
#undef PG8_SCHED
}
}

constexpr int DM = 2048, NB = 8, TT = 2048, NDB = 128, NTS = 8, DFF = 5632;
constexpr int MP = NB * TT, MS = NDB * NTS, MTOT = MP + MS;
constexpr int NSEQ = NDB + NB;
constexpr int NIN = 5632, NEXTRA = 64;
constexpr int GLAW = 3072;
constexpr int XROWS = NSEQ * 4 * 128;
constexpr float LN_EPS = 1e-5f, ALPHA = 1.189207115002721f, LOG2E = 1.4426950408889634f;
constexpr int NWAVES = 8;

constexpr size_t O_YP = 0, O_YS = 33554432, O_CMPP = 35651584, O_SLCP = 44040192, O_WINP = 52428800, O_GLAP = 54525952,
                 O_CMPS = 55574528, O_SLCS = 56098816, O_WINS = 56623104, O_GLAS = 90177536, O_END = 106954752;

constexpr size_t MiB = 1u << 20;
constexpr size_t WS_CTL = 0, CTL_ZERO_BYTES = 64 * 1024;
constexpr size_t WS_SMALL = 1 * MiB;
constexpr size_t WS_W1A = 2 * MiB;
constexpr size_t WS_W1B = WS_W1A + 44 * MiB;
constexpr size_t WS_WIN = WS_W1B + 22 * MiB;
constexpr size_t WS_WOUT = WS_WIN + 23 * MiB;
constexpr size_t WS_W2A = WS_WOUT + 8 * MiB;
constexpr size_t WS_W2B = WS_W2A + 44 * MiB;
constexpr size_t WS_CW1 = WS_W2B + 22 * MiB;
constexpr size_t WS_XB = WS_CW1 + 1 * MiB;
constexpr size_t WS_HB = WS_XB + 68 * MiB;
constexpr size_t WS_ZF = WS_HB + 187 * MiB;
constexpr size_t WS_GLAIN = WS_ZF + 136 * MiB;
constexpr size_t WS_NQ = WS_GLAIN + 204 * MiB;
constexpr size_t WS_EXTRA = WS_NQ + 34 * MiB;
constexpr size_t WS_WINROWS = WS_EXTRA + 5 * MiB;
constexpr size_t WS_ORAW = WS_WINROWS + 32 * MiB;
constexpr size_t WS_MIX = WS_ORAW + 64 * MiB;
constexpr size_t WS_XBLK = WS_MIX + 68 * MiB;
constexpr size_t WS_ZC = WS_XBLK + 272 * MiB;
constexpr size_t WS_KCMP = WS_ZC + 136 * MiB;
constexpr size_t WS_GQ = WS_KCMP + 34 * MiB;
constexpr size_t WS_GKT = WS_GQ + 16 * MiB;
constexpr size_t WS_GA = WS_GKT + 16 * MiB;
constexpr size_t WS_GVT = WS_GA + 8 * MiB;
constexpr size_t WS_GD = WS_GVT + 32 * MiB;
constexpr size_t WS_SLAB = WS_GD + 1 * MiB;
constexpr size_t WS_KB16 = WS_SLAB + 32 * MiB;
constexpr size_t WS_VT16 = WS_KB16 + 16 * MiB;
constexpr size_t WS_KC16 = WS_VT16 + 16 * MiB;
constexpr size_t WS_VCT16 = WS_KC16 + 9 * MiB;
constexpr size_t WS_END = WS_VCT16 + 9 * MiB;
constexpr int CW_TMO = 0, CW_CODE = 1, CW_BAR = 4096;

constexpr int RING_BYTES = 131072;
constexpr int LDSCTL_OFF = RING_BYTES, MISC_OFF = LDSCTL_OFF + 320;
constexpr int LDS_BYTES = 147456;

#define GAS __attribute__((address_space(1)))
#define LAS __attribute__((address_space(3)))
typedef unsigned short bf16;
typedef float f32x2 __attribute__((ext_vector_type(2)));
typedef float f32x4 __attribute__((ext_vector_type(4)));
typedef float f32x16 __attribute__((ext_vector_type(16)));
typedef short bf16x8 __attribute__((ext_vector_type(8)));
typedef short s16x4 __attribute__((ext_vector_type(4)));
typedef unsigned u32x2 __attribute__((ext_vector_type(2)));
typedef unsigned u32x4 __attribute__((ext_vector_type(4)));
typedef __bf16 bf16x2_t __attribute__((ext_vector_type(2)));
typedef GAS unsigned gu32;
#define RLX_AGENT __ATOMIC_RELAXED, __HIP_MEMORY_SCOPE_AGENT
#define LDS_WAIT() asm volatile("s_waitcnt lgkmcnt(0)" ::: "memory")
#define VM_WAIT() asm volatile("s_waitcnt vmcnt(0)" ::: "memory")
#define DI __device__ __forceinline__

DI unsigned pk2(float lo, float hi) { f32x2 v = {lo, hi}; bf16x2_t b = __builtin_convertvector(v, bf16x2_t); return __builtin_bit_cast(unsigned, b); }
DI float wave_sum(float v) {
#pragma unroll
    for (int o = 1; o < 64; o <<= 1) v += __shfl_xor(v, o);
    return v;
}
DI float fexp2(float x) { return __builtin_amdgcn_exp2f(x); }
DI float frcp(float x) { return __builtin_amdgcn_rcpf(x); }
DI float sigmoidf_(float x) { return frcp(1.f + fexp2(-x * LOG2E)); }
DI float siluf_(float x) { return x * sigmoidf_(x); }


struct EpiSwiGLU {
    static constexpr bool PERM = true, AFTER_DRAIN = false;
    bf16* H;
    DI void operator()(const f32x4 (&acc)[2][2][4][2], const pg8::Unit& u, int wr, int wc, int fr, int fq) const {
        const int row0 = u.pm * 256 + wr * 64 + fr, col0 = u.pn * 128 + wc * 32 + 8 * fq;
#pragma unroll
        for (int ai = 0; ai < 2; ++ai)
#pragma unroll
            for (int m = 0; m < 4; ++m) {
                const f32x4 g0 = acc[ai][0][m][0], g1 = acc[ai][0][m][1], u0 = acc[ai][1][m][0], u1 = acc[ai][1][m][1];
                u32x4 w;
                w.x = pk2(siluf_(g0[0]) * u0[0], siluf_(g0[1]) * u0[1]); w.y = pk2(siluf_(g0[2]) * u0[2], siluf_(g0[3]) * u0[3]);
                w.z = pk2(siluf_(g1[0]) * u1[0], siluf_(g1[1]) * u1[1]); w.w = pk2(siluf_(g1[2]) * u1[2], siluf_(g1[3]) * u1[3]);
                *(u32x4*)(H + (size_t)(row0 + ai * 128 + m * 16) * DFF + col0) = w;
            }
    }
};

DI f32x4 bf4_lo(u32x4 q) { return (f32x4){__builtin_bit_cast(float, q.x << 16), __builtin_bit_cast(float, q.x & 0xffff0000u), __builtin_bit_cast(float, q.y << 16), __builtin_bit_cast(float, q.y & 0xffff0000u)}; }
DI f32x4 bf4_hi(u32x4 q) { return (f32x4){__builtin_bit_cast(float, q.z << 16), __builtin_bit_cast(float, q.z & 0xffff0000u), __builtin_bit_cast(float, q.w << 16), __builtin_bit_cast(float, q.w & 0xffff0000u)}; }
struct EpiResid {
    static constexpr bool PERM = true, AFTER_DRAIN = false;
    const float* res; bf16* out; float sc;
    DI void operator()(const f32x4 (&acc)[2][2][4][2], const pg8::Unit& u, int wr, int wc, int fr, int fq) const {
        const int row0 = u.pm * 256 + wr * 64 + fr, col0 = u.pn * 256 + wc * 32 + 8 * fq;
#pragma unroll
        for (int ai = 0; ai < 2; ++ai) {
            f32x4 r[4][2][2];
#pragma unroll
            for (int m = 0; m < 4; ++m)
#pragma unroll
                for (int bj = 0; bj < 2; ++bj)
#pragma unroll
                    for (int n = 0; n < 2; ++n) r[m][bj][n] = __builtin_nontemporal_load((const f32x4*)(res + (size_t)(row0 + ai * 128 + m * 16) * DM + col0 + bj * 128 + n * 4));
            asm volatile("" ::: "memory");
#pragma unroll
            for (int m = 0; m < 4; ++m)
#pragma unroll
                for (int bj = 0; bj < 2; ++bj) { const f32x4 a = r[m][bj][0] * ALPHA + acc[ai][bj][m][0] * sc, b = r[m][bj][1] * ALPHA + acc[ai][bj][m][1] * sc;
                    *(u32x4*)(out + (size_t)(row0 + ai * 128 + m * 16) * DM + col0 + bj * 128) = (u32x4){pk2(a[0], a[1]), pk2(a[2], a[3]), pk2(b[0], b[1]), pk2(b[2], b[3])}; }
        }
    }
};
struct EpiResid16 {
    static constexpr bool PERM = true, AFTER_DRAIN = false;
    const bf16* res; bf16* out; float sc;
    DI void operator()(const f32x4 (&acc)[2][2][4][2], const pg8::Unit& u, int wr, int wc, int fr, int fq) const {
        const int row0 = u.pm * 256 + wr * 64 + fr, col0 = u.pn * 256 + wc * 32 + 8 * fq;
#pragma unroll
        for (int ai = 0; ai < 2; ++ai) {
            u32x4 r[4][2];
#pragma unroll
            for (int m = 0; m < 4; ++m)
#pragma unroll
                for (int bj = 0; bj < 2; ++bj) r[m][bj] = *(const u32x4*)(res + (size_t)(row0 + ai * 128 + m * 16) * DM + col0 + bj * 128);
            asm volatile("" ::: "memory");
#pragma unroll
            for (int m = 0; m < 4; ++m)
#pragma unroll
                for (int bj = 0; bj < 2; ++bj) { const f32x4 a = bf4_lo(r[m][bj]) * ALPHA + acc[ai][bj][m][0] * sc, b = bf4_hi(r[m][bj]) * ALPHA + acc[ai][bj][m][1] * sc;
                    *(u32x4*)(out + (size_t)(row0 + ai * 128 + m * 16) * DM + col0 + bj * 128) = (u32x4){pk2(a[0], a[1]), pk2(a[2], a[3]), pk2(b[0], b[1]), pk2(b[2], b[3])}; }
        }
    }
};

struct EpiZ {
    static constexpr bool PERM = true, AFTER_DRAIN = false;
    bf16* Z;
    DI void operator()(const f32x4 (&acc)[2][2][4][2], const pg8::Unit& u, int wr, int wc, int fr, int fq) const {
        const int row0 = u.pm * 256 + wr * 64 + fr, col0 = wc * 32 + 8 * fq;
#pragma unroll
        for (int ai = 0; ai < 2; ++ai)
#pragma unroll
            for (int m = 0; m < 4; ++m) {
                const size_t off = (size_t)(row0 + ai * 128 + m * 16) * 256 + col0;
#pragma unroll
                for (int bj = 0; bj < 2; ++bj) { const f32x4 a = acc[ai][bj][m][0], b = acc[ai][bj][m][1];
                    *(u32x4*)(Z + off + bj * 128) = (u32x4){pk2(a[0], a[1]), pk2(a[2], a[3]), pk2(b[0], b[1]), pk2(b[2], b[3])}; }
            }
    }
};
struct CmpOrder {
    int G, c;
    DI bool next(int i, pg8::Unit& u) const { const int L = i * G + c; if (L >= 2 * (XROWS / 256)) return false; u.pm = L; u.pn = L / (XROWS / 256); u.kb = 0; return true; }
    DI void a_ready(const pg8::Unit&) const {}
    DI void done(const pg8::Unit&) const {}
};

constexpr int NSPLIT = 4;
struct SplitOrder {
    int G, c, kslice_bytes;
    DI bool next(int i, pg8::Unit& u) const { const int L = i * G + c; if (L >= 32 * NSPLIT) return false; const int t = L / NSPLIT, ks = L % NSPLIT; u.pm = MP / 256 + (t >> 3); u.pn = t & 7; u.kb = ks * kslice_bytes; return true; }
    DI void a_ready(const pg8::Unit&) const {}
    DI void done(const pg8::Unit&) const {}
};
struct EpiSlab {
    static constexpr bool PERM = false, AFTER_DRAIN = false;
    float* slab; int kslice_bytes;
    DI void operator()(const f32x4 (&acc)[2][2][4][2], const pg8::Unit& u, int wr, int wc, int fr, int fq) const {
        const int row0 = (u.pm - MP / 256) * 256 + wr * 64 + fr, col0 = u.pn * 256 + wc * 32 + 4 * fq;
        float* dst = slab + (size_t)(u.kb / kslice_bytes) * MS * DM;
#pragma unroll
        for (int ai = 0; ai < 2; ++ai)
#pragma unroll
            for (int m = 0; m < 4; ++m) {
                const size_t off = (size_t)(row0 + ai * 128 + m * 16) * DM + col0;
#pragma unroll
                for (int bj = 0; bj < 2; ++bj)
#pragma unroll
                    for (int n = 0; n < 2; ++n) *(f32x4*)(dst + off + bj * 128 + n * 16) = acc[ai][bj][m][n];
            }
    }
};

struct EpiInProj {
    static constexpr bool PERM = false, AFTER_DRAIN = false;
    bf16* glain; bf16* nq; float* out; float* winrows; bf16* xblk; bf16* kb16; bf16* vt16;
    DI void operator()(const f32x4 (&acc)[2][2][4][2], const pg8::Unit& u, int wr, int wc, int fr, int fq) const {
        const int row0 = u.pm * 256 + wr * 64 + fr, pn = u.pn;
        if (pn < 12) {
            const float sc = pn < 2 ? 0.08838834764831845f : 1.f;
            const int col0 = pn * 256 + wc * 32 + 4 * fq;
#pragma unroll
            for (int ai = 0; ai < 2; ++ai)
#pragma unroll
                for (int m = 0; m < 4; ++m) {
                    const size_t off = (size_t)(row0 + ai * 128 + m * 16) * GLAW + col0;
#pragma unroll
                    for (int bj = 0; bj < 2; ++bj)
#pragma unroll
                        for (int n = 0; n < 2; ++n) { const f32x4 a = acc[ai][bj][m][n] * sc; *(u32x2*)(glain + off + bj * 128 + n * 16) = (u32x2){pk2(a[0], a[1]), pk2(a[2], a[3])}; }
                }
            return;
        }
        const int dlo = 16 * (wc & 1) + 4 * fq;
        float frev[4];
#pragma unroll
        for (int i = 0; i < 4; ++i) frev[i] = fexp2(-(float)(dlo + i) * (13.287712379549449f / 32.f)) * 0.15915494309189535f;
        const int which = pn - 16;
        const bool dorope = (pn < 16) || ((which & 1) == 0);
#pragma unroll
        for (int ai = 0; ai < 2; ++ai)
#pragma unroll
            for (int m = 0; m < 4; ++m) {
                const int row = row0 + ai * 128 + m * 16;
                const bool samp = row >= MP;
                const int srow = row - MP;
                const int pos = samp ? (TT + (srow & 7)) : (row & (TT - 1));
                float cs[4], sn[4];
#pragma unroll
                for (int i = 0; i < 4; ++i) { float rev = (float)pos * frev[i]; rev = rev - floorf(rev); cs[i] = __builtin_amdgcn_cosf(rev); sn[i] = __builtin_amdgcn_sinf(rev); }
#pragma unroll
                for (int bj = 0; bj < 2; ++bj) {
                    f32x4 x1 = acc[ai][bj][m][0], x2 = acc[ai][bj][m][1], o1, o2;
                    if (dorope) {
#pragma unroll
                        for (int i = 0; i < 4; ++i) { o1[i] = x1[i] * cs[i] - x2[i] * sn[i]; o2[i] = x2[i] * cs[i] + x1[i] * sn[i]; }
                    } else { o1 = x1; o2 = x2; }
                    const int hh = 2 * bj + (wc >> 1);
                    if (pn < 16) {
                        const int head = (pn - 12) * 4 + hh;
                        bf16* q = nq + (size_t)row * 1024 + head * 64 + dlo;
                        u32x2 w1, w2; w1.x = pk2(o1[0] * 0.125f, o1[1] * 0.125f); w1.y = pk2(o1[2] * 0.125f, o1[3] * 0.125f); w2.x = pk2(o2[0] * 0.125f, o2[1] * 0.125f); w2.y = pk2(o2[2] * 0.125f, o2[3] * 0.125f);
                        *(u32x2*)q = w1; *(u32x2*)(q + 32) = w2;
                    } else {
                        const int br = which >> 1, kvsel = which & 1;
                        const int inrow = kvsel * 256 + hh * 64 + dlo;
                        float* dst;
                        if (br == 0) dst = out + (samp ? O_CMPS + (size_t)srow * 512 : O_CMPP + (size_t)row * 512);
                        else if (br == 1) dst = out + (samp ? O_SLCS + (size_t)srow * 512 : O_SLCP + (size_t)row * 512);
                        else dst = samp ? out + O_WINS + ((size_t)(srow >> 3) * 512 + 504 + (srow & 7)) * 512 : winrows + (size_t)row * 512;
                        *(f32x4*)(dst + inrow) = o1; *(f32x4*)(dst + inrow + 32) = o2;
                        if (br == 2 && !samp && (row & (TT - 1)) >= TT - 512) {
                            float* d2 = out + O_WINP + ((size_t)(row >> 11) * 512 + (row & (TT - 1)) - (TT - 512)) * 512 + inrow;
                            *(f32x4*)d2 = o1; *(f32x4*)(d2 + 32) = o2;
                        }
                        if (br != 0 && !samp) {
                            const int b = row >> 11, t = row & (TT - 1);
                            bf16* kp = (kvsel == 0 ? kb16 : vt16) + (((size_t)(br - 1) * NB * 4 + b * 4 + hh) * TT + t) * 64 + dlo;
                            u32x2 w1, w2; w1.x = pk2(o1[0], o1[1]); w1.y = pk2(o1[2], o1[3]); w2.x = pk2(o2[0], o2[1]); w2.y = pk2(o2[2], o2[3]);
                            *(u32x2*)kp = w1; *(u32x2*)(kp + 32) = w2;
                        }
                        if (br == 0 && !samp) {
                            const int b = row >> 11, t = row & (TT - 1);
                            bf16* xb = xblk + ((size_t)kvsel * XROWS + (size_t)((NDB + b) * 4 + hh) * 128 + (t >> 4)) * 1024 + (t & 15) * 64 + dlo;
                            u32x2 w1, w2; w1.x = pk2(o1[0], o1[1]); w1.y = pk2(o1[2], o1[3]); w2.x = pk2(o2[0], o2[1]); w2.y = pk2(o2[2], o2[3]);
                            *(u32x2*)xb = w1; *(u32x2*)(xb + 32) = w2;
                        }
                    }
                }
            }
    }
};
#define XB_TMO      128
#define XB_XCNT(j)  (256  + 64 * (j))
#define XB_XSUB(j)  (1280 + 64 * (j))
#define XB_XGEN(j)  (2304 + 64 * (j))
#define XB_TOP      3328
#define XB_TOPGEN   3392
#define XCD_BAR_WORDS 3456
#define XB_SPIN_CAP (1u << 18)

__device__ __forceinline__ unsigned xb_ld(unsigned* p)              { return __hip_atomic_load(p, __ATOMIC_RELAXED, __HIP_MEMORY_SCOPE_AGENT); }
__device__ __forceinline__ unsigned xb_add(unsigned* p, unsigned v) { return __hip_atomic_fetch_add(p, v, __ATOMIC_RELAXED, __HIP_MEMORY_SCOPE_AGENT); }
__device__ __forceinline__ unsigned xb_xcc_id() { return (unsigned)__builtin_amdgcn_s_getreg((3 << 11) | 20) & 0xFu; }
#define XB_SPIN(cond, bar) do { unsigned _sp = 0; while (cond) { __builtin_amdgcn_s_sleep(1); \
    if ((++_sp & 255u) == 0u) { if (xb_ld(&(bar)[XB_TMO])) break; if (_sp > XB_SPIN_CAP) { atomicAdd(&(bar)[XB_TMO], 1u); break; } } } } while (0)

struct XcdBarrier {
    unsigned* bar; unsigned x;
    volatile LAS unsigned* st;
};

__device__ __forceinline__ XcdBarrier xcd_barrier_post(unsigned* bar, volatile LAS unsigned* st) {
    XcdBarrier b; b.bar = bar; b.x = xb_xcc_id(); b.st = st;
    if (threadIdx.x == 0) (void)xb_add(&bar[XB_XCNT(b.x)], 1u);
    return b;
}
__device__ __forceinline__ void xcd_barrier_complete(unsigned* bar, unsigned x, unsigned& nloc, unsigned& nx) {
    const unsigned G = gridDim.x * gridDim.y * gridDim.z;
    unsigned sum, cnt, mine, sp = 0u;
    for (;;) {
        sum = 0u; cnt = 0u; mine = 0u;
#pragma unroll
        for (unsigned j = 0; j < 16; ++j) { const unsigned c = xb_ld(&bar[XB_XCNT(j)]); sum += c; cnt += (c > 0u) ? 1u : 0u; mine = (j == x) ? c : mine; }
        if (sum == G) break;
        __builtin_amdgcn_s_sleep(1);
        if ((++sp & 255u) == 0u) { if (xb_ld(&bar[XB_TMO])) break; if (sp > XB_SPIN_CAP) { atomicAdd(&bar[XB_TMO], 1u); break; } }
    }
    nloc = mine > 0u ? mine : 1u; nx = cnt > 0u ? cnt : 1u;
}

__device__ __forceinline__ void xcd_barrier(const XcdBarrier& b) {
    asm volatile("s_waitcnt vmcnt(0)" ::: "memory");
    __syncthreads();
    if (threadIdx.x == 0) {
        unsigned* bar = b.bar;
        __builtin_amdgcn_s_waitcnt(0);
        unsigned nloc = b.st[0], nx = b.st[1];
        if (nloc == 0u) { xcd_barrier_complete(bar, b.x, nloc, nx); b.st[0] = nloc; b.st[1] = nx; }
        const unsigned old = xb_add(&bar[XB_XSUB(b.x)], 1u);
        const unsigned gen = old / nloc;
        if (old + 1u == (gen + 1u) * nloc) {
            __builtin_amdgcn_fence(__ATOMIC_RELEASE, "agent");
            asm volatile("s_waitcnt vmcnt(0)" ::: "memory");
            const unsigned og = xb_add(&bar[XB_TOP], 1u);
            const unsigned tg = og / nx;
            if (og + 1u == (tg + 1u) * nx) xb_add(&bar[XB_TOPGEN], 1u);
            else XB_SPIN(xb_ld(&bar[XB_TOPGEN]) == tg, bar);
            __builtin_amdgcn_fence(__ATOMIC_ACQUIRE, "agent");
            xb_add(&bar[XB_XGEN(b.x)], 1u);
            asm volatile("s_waitcnt vmcnt(0)" ::: "memory");
        } else {
            XB_SPIN(xb_ld(&bar[XB_XGEN(b.x)]) == gen, bar);
            __builtin_amdgcn_fence(__ATOMIC_ACQUIRE, "agent");
            asm volatile("s_waitcnt vmcnt(0)" ::: "memory");
        }
    }
    __syncthreads();
}

struct Frame {
    LAS unsigned char* lds;
    volatile LAS unsigned* MISC;
    gu32* ctl;
    int tid, lane, wave, vcu, G;
    const float *x_p, *x_s, *c_cmp, *c_slc, *c_win, *st_gla; const int* ptab;
    const float *w1a, *w1b, *w_in, *w_g2, *b_g2, *gnorm, *cpos, *cw1, *cw2, *w_out, *w2a, *w2b, *ln_g, *ln_b;
    float* out;
    bf16 *W1A, *W1B, *WIN, *WOUT, *W2A, *W2B, *CW1, *XB, *HB, *NQ, *MIX, *XBLK, *GQ, *GKT, *GA, *GVT, *KB16, *VT16, *KC16, *VCT16, *G16;
    float *CBIAS, *ZF, *EXTRA, *WINROWS, *ORAW, *ZC, *KCMP, *GD, *SLAB;
};

constexpr int W2A_S1 = 4500, W2A_S2 = 9000, WIN_DB1 = 20, WIN_DB2 = 84;
struct MapIdent { DI int operator()(int n) const { return n; } };
struct MapOff { int off; DI int operator()(int n) const { return off + n; } };
struct MapFfnIn { DI int operator()(int n) const { const int up = n >= DFF, c = up ? n - DFF : n; return (c >> 7) * 256 + up * 128 + (c & 127); } };
struct MapInProj {
    DI int operator()(int n) const {
        if (n < 2048) return n;
        if (n < 2064) return NIN + (n - 2048);
        if (n < 3088) return 2048 + (n - 2064);
        if (n < 5648) { const int c = n - 3088, d = c & 63, q = d >> 4; const int p = q == 1 ? d + 16 : (q == 2 ? d - 16 : d); return 3072 + (c - d) + p; }
        return n;
    }
};
template <class RowMap>
DI void transpose_item(const float* W, int ldw, int k0, int n0, bf16* WT, int ldt, int dcol0, const RowMap& rm, LAS float* scr, int lane) {
    f32x4 v[8];
#pragma unroll
    for (int i = 0; i < 8; ++i) v[i] = *(const f32x4*)(W + (size_t)(k0 + 8 * i + (lane >> 3)) * ldw + n0 + 4 * (lane & 7));
#pragma unroll
    for (int i = 0; i < 8; ++i) { LAS float* d = scr + (8 * i + (lane >> 3)) * 33 + 4 * (lane & 7); d[0] = v[i][0]; d[1] = v[i][1]; d[2] = v[i][2]; d[3] = v[i][3]; }
    LDS_WAIT(); asm volatile("" ::: "memory");
    const int c = lane & 7;
#pragma unroll
    for (int j = 0; j < 4; ++j) { const int n = (lane >> 3) + 8 * j; const LAS float* s = scr + (8 * c) * 33 + n;
        u32x4 o; o.x = pk2(s[0 * 33], s[1 * 33]); o.y = pk2(s[2 * 33], s[3 * 33]); o.z = pk2(s[4 * 33], s[5 * 33]); o.w = pk2(s[6 * 33], s[7 * 33]);
        *(u32x4*)(WT + (size_t)rm(n0 + n) * ldt + dcol0 + 8 * c) = o; }
    LDS_WAIT(); asm volatile("" ::: "memory");
}
template <class RowMap>
DI void transpose_matrix(const float* W, int K, int N, bf16* WT, const RowMap& rm, LAS float* scr, int gw, int NGW, int lane, int it0 = 0, int it1 = 0x7fffffff) {
    const int nblk = N / 32, nitems = (K / 64) * nblk < it1 ? (K / 64) * nblk : it1;
    for (int it = it0 + gw; it < nitems; it += NGW) { const int kb = it / nblk, nb = it % nblk; transpose_item(W, N, 64 * kb, 32 * nb, WT, K, 64 * kb, rm, scr, lane); }
}

DI void xblk_part(Frame& F, int rank, int nranks) {
    const int gw = rank * NWAVES + F.wave, NGW = nranks * NWAVES, lane = F.lane;
    for (int it0 = gw * 4; it0 < NDB * 2048; it0 += NGW * 4) {
        f32x4 v[4][2];
#pragma unroll
        for (int q = 0; q < 4; ++q) { const int it = it0 + q, s = it >> 11, row = it & 2047; const int page = F.ptab[s * 16 + (row >> 7)];
            const float* src = F.c_cmp + ((size_t)page * 128 + (row & 127)) * 512;
            v[q][0] = __builtin_nontemporal_load((const f32x4*)(src + 4 * lane)); v[q][1] = __builtin_nontemporal_load((const f32x4*)(src + 4 * (lane + 64))); }
#pragma unroll
        for (int q = 0; q < 4; ++q) { const int it = it0 + q, s = it >> 11, row = it & 2047;
#pragma unroll
            for (int j = 0; j < 2; ++j) { const int e = lane + 64 * j, kvsel = e >> 6, h = (e >> 4) & 3, d4 = (e & 15) * 4;
                u32x2 w; w.x = pk2(v[q][j][0], v[q][j][1]); w.y = pk2(v[q][j][2], v[q][j][3]);
                *(u32x2*)(F.XBLK + ((size_t)kvsel * XROWS + (size_t)(s * 4 + h) * 128 + (row >> 4)) * 1024 + (row & 15) * 64 + d4) = w; } }
    }
}
DI void p0_prologue(Frame& F) {
    LAS float* scr = (LAS float*)(F.lds + F.wave * 16384);
    const int gw = F.vcu * NWAVES + F.wave, NGW = F.G * NWAVES, lane = F.lane;
    transpose_matrix(F.w1a, DM, 2 * DFF, F.W1A, MapFfnIn{}, scr, gw, NGW, lane);
    const int gr = NGW - 1 - gw, gs = (gw + NGW / 2) % NGW, gt = (gw + NGW / 2 - NGW / 8) % NGW;
    for (int it = gs; it < 2 * 32 * 4; it += NGW) { const int kv = it >> 7, kb = (it >> 2) & 31, nb = it & 3;
        transpose_item(F.cw1 + (size_t)kv * 2048 * 128, 128, 64 * kb, 32 * nb, F.CW1 + (size_t)kv * 256 * 1024, 1024, (64 * kb) & 1023, MapOff{(kb >> 4) * 128}, scr, lane); }
    for (int it = gt; it < 256; it += NGW) { const int kv = it >> 7, n = it & 127; float s = 0.f;
        for (int k = lane; k < 2048; k += 64) s += F.cpos[kv * 2048 + k] * F.cw1[((size_t)kv * 2048 + k) * 128 + n];
        s = wave_sum(s); if (lane == 0) F.CBIAS[it] = s; }
    for (int m0 = 2 * gr; m0 < MTOT; m0 += 2 * NGW) {
        f32x4 v[2][8];
#pragma unroll
        for (int q = 0; q < 2; ++q) { const int m = m0 + q; const float* xr = m < MP ? F.x_p + (size_t)m * DM : F.x_s + (size_t)(m - MP) * DM;
#pragma unroll
            for (int j = 0; j < 8; ++j) v[q][j] = __builtin_nontemporal_load((const f32x4*)(xr + 4 * (lane + 64 * j))); }
#pragma unroll
        for (int q = 0; q < 2; ++q) { bf16* o = F.XB + (size_t)(m0 + q) * DM;
#pragma unroll
            for (int j = 0; j < 8; ++j) { u32x2 w; w.x = pk2(v[q][j][0], v[q][j][1]); w.y = pk2(v[q][j][2], v[q][j][3]); *(u32x2*)(o + 4 * (lane + 64 * j)) = w; } }
    }

}
DI void wincopy_part(Frame& F, int rank, int nranks, int db0, int db1) {
    const size_t per = (size_t)504 * 128, tot = (size_t)(db1 - db0) * per;
    const size_t step = (size_t)nranks * 512;
    for (size_t i0 = (size_t)rank * 512 + F.tid; i0 < tot; i0 += 8 * step) {
        f32x4 v[8];
#pragma unroll
        for (int u = 0; u < 8; ++u) { const size_t i = i0 + u * step; if (i < tot) { const size_t db = db0 + i / per, r = i % per; v[u] = __builtin_nontemporal_load((const f32x4*)F.c_win + db * (512 * 128) + 8 * 128 + r); } }
#pragma unroll
        for (int u = 0; u < 8; ++u) { const size_t i = i0 + u * step; if (i < tot) { const size_t db = db0 + i / per, r = i % per; __builtin_nontemporal_store(v[u], (f32x4*)(F.out + O_WINS) + db * (512 * 128) + r); } }
    }
}

DI void late_work(Frame& F, int part, int rank, int nranks) {
    LAS float* scr = (LAS float*)(F.lds + F.wave * 16384);
    const int gw = rank * NWAVES + F.wave, NGW = nranks * NWAVES, lane = F.lane;
    __syncthreads();
    if (part == 1) { transpose_matrix(F.w1b, DFF, DM, F.W1B, MapIdent{}, scr, gw, NGW, lane); transpose_matrix(F.w_out, DM, DM, F.WOUT, MapIdent{}, scr, gw, NGW, lane); }
    else if (part == 2) { transpose_matrix(F.w_in, DM, NIN + NEXTRA, F.WIN, MapInProj{}, scr, gw, NGW, lane); transpose_matrix(F.w2a, DM, 2 * DFF, F.W2A, MapFfnIn{}, scr, gw, NGW, lane, 0, W2A_S1); }
    else if (part == 4) transpose_matrix(F.w2a, DM, 2 * DFF, F.W2A, MapFfnIn{}, scr, gw, NGW, lane, W2A_S1, W2A_S2);
    else if (part == 8) transpose_matrix(F.w2a, DM, 2 * DFF, F.W2A, MapFfnIn{}, scr, gw, NGW, lane, W2A_S2);
    else if (part == 10) { transpose_matrix(F.w2b, DFF, DM, F.W2B, MapIdent{}, scr, gw, NGW, lane); wincopy_part(F, rank, nranks, 0, WIN_DB1); }
    else if (part == 11) wincopy_part(F, rank, nranks, WIN_DB1, WIN_DB2);
    else if (part == 5) wincopy_part(F, rank, nranks, WIN_DB2, NDB);
    __syncthreads();
}
DI void late_tail(Frame& F, int part, int bx, int busy) {
    if (busy % F.G == 0) late_work(F, part, bx, F.G); else if (bx >= busy % F.G) late_work(F, part, bx - busy % F.G, F.G - busy % F.G);
}
DI void ln_finish(f32x4 (&v)[8], int m, int lane, float* outf, bf16* outb, const float* g, const float* b) {
    float s = 0.f;
#pragma unroll
    for (int j = 0; j < 8; ++j) s += (v[j][0] + v[j][1]) + (v[j][2] + v[j][3]);
    const float mean = wave_sum(s) * (1.f / DM); float s2 = 0.f;
#pragma unroll
    for (int j = 0; j < 8; ++j) { v[j] = v[j] - mean; s2 += (v[j][0] * v[j][0] + v[j][1] * v[j][1]) + (v[j][2] * v[j][2] + v[j][3] * v[j][3]); }
    const float rstd = 1.f / sqrtf(wave_sum(s2) * (1.f / DM) + LN_EPS);
#pragma unroll
    for (int j = 0; j < 4; ++j) { const int c = 8 * (lane + 64 * j);
        const f32x4 y0 = v[2 * j] * rstd * *(const f32x4*)(g + c) + *(const f32x4*)(b + c), y1 = v[2 * j + 1] * rstd * *(const f32x4*)(g + c + 4) + *(const f32x4*)(b + c + 4);
        if (outf) { __builtin_nontemporal_store(y0, (f32x4*)(outf + (size_t)m * DM + c)); __builtin_nontemporal_store(y1, (f32x4*)(outf + (size_t)m * DM + c + 4)); }
        if (outb) *(u32x4*)(outb + (size_t)m * DM + c) = (u32x4){pk2(y0[0], y0[1]), pk2(y0[2], y0[3]), pk2(y1[0], y1[1]), pk2(y1[2], y1[3])}; }
}
DI void ln_prompt_row(const bf16* zb, int m, int mpf, u32x4 (&nq)[4], int lane, float* outf, bf16* outb, const float* g, const float* b) {
    f32x4 v[8];
#pragma unroll
    for (int j = 0; j < 4; ++j) { v[2 * j] = bf4_lo(nq[j]); v[2 * j + 1] = bf4_hi(nq[j]); }
    if (mpf < MP) {
#pragma unroll
        for (int j = 0; j < 4; ++j) nq[j] = *(const u32x4*)(zb + (size_t)mpf * DM + 8 * (lane + 64 * j));
    }
    ln_finish(v, m, lane, outf, outb, g, b);
}
DI void ln_phase(Frame& F, const bf16* zb, float* outf, bf16* outb, const float* g, const float* b, const float* res_s, const bf16* res16, float sc) {
    const int gw = F.vcu * NWAVES + F.wave, NGW = F.G * NWAVES, lane = F.lane;
    u32x4 qa[4], qb[4], qc[4];
    if (gw < MP) {
#pragma unroll
        for (int j = 0; j < 4; ++j) qa[j] = *(const u32x4*)(zb + (size_t)gw * DM + 8 * (lane + 64 * j));
    }
    if (gw + NGW < MP) {
#pragma unroll
        for (int j = 0; j < 4; ++j) qb[j] = *(const u32x4*)(zb + (size_t)(gw + NGW) * DM + 8 * (lane + 64 * j));
    }
    if (gw + 2 * NGW < MP) {
#pragma unroll
        for (int j = 0; j < 4; ++j) qc[j] = *(const u32x4*)(zb + (size_t)(gw + 2 * NGW) * DM + 8 * (lane + 64 * j));
    }
    for (int ms = F.vcu + F.G * F.wave; ms < MS; ms += NGW) { const size_t o = (size_t)ms * DM; f32x4 v[8];
#pragma unroll
        for (int j = 0; j < 4; ++j)
#pragma unroll
            for (int hh = 0; hh < 2; ++hh) { const size_t e = o + 8 * (lane + 64 * j) + 4 * hh; f32x4 a = *(const f32x4*)(F.SLAB + e);
#pragma unroll
                for (int q = 1; q < NSPLIT; ++q) a = a + *(const f32x4*)(F.SLAB + (size_t)q * MS * DM + e);
                f32x4 rv;
                if (res_s) rv = *(const f32x4*)(res_s + e);
                else { const u32x2 q2 = *(const u32x2*)(res16 + e); rv = (f32x4){__builtin_bit_cast(float, q2.x << 16), __builtin_bit_cast(float, q2.x & 0xffff0000u), __builtin_bit_cast(float, q2.y << 16), __builtin_bit_cast(float, q2.y & 0xffff0000u)}; }
                v[2 * j + hh] = rv * ALPHA + a * sc; }
        ln_finish(v, MP + ms, lane, outf, outb, g, b);
    }
    for (int m = gw; m < MP; m += 3 * NGW) {
        ln_prompt_row(zb, m, m + 3 * NGW, qa, lane, outf, outb, g, b);
        if (m + NGW < MP) ln_prompt_row(zb, m + NGW, m + 4 * NGW, qb, lane, outf, outb, g, b);
        if (m + 2 * NGW < MP) ln_prompt_row(zb, m + 2 * NGW, m + 5 * NGW, qc, lane, outf, outb, g, b);
    }
}

struct XOps { bf16x8 a[4]; bf16x8 b[4][4]; };
DI void xops_load(XOps& o, const bf16* ap, const bf16* bp, int k0) {
#pragma unroll
    for (int ks = 0; ks < 4; ++ks) { o.a[ks] = *(const bf16x8*)(ap + k0 + 32 * ks);
#pragma unroll
        for (int n = 0; n < 4; ++n) o.b[ks][n] = *(const bf16x8*)(bp + (size_t)n * 16 * DM + k0 + 32 * ks); }
}
DI void xops_mma(const XOps& o, f32x4 (&acc)[4]) {
#pragma unroll
    for (int ks = 0; ks < 4; ++ks)
#pragma unroll
        for (int n = 0; n < 4; ++n) acc[n] = __builtin_amdgcn_mfma_f32_16x16x32_bf16(o.a[ks], o.b[ks][n], acc[n], 0, 0, 0);
}
DI void extra_phase(Frame& F, int rank, int nranks) {
    const int lane = F.lane, w = F.wave, r = lane & 15, kq = lane >> 4, tile = w >> 2, q4 = w & 3;
    LAS float* PART = (LAS float*)F.lds;
    const bf16* Bt = F.WIN + (size_t)NIN * DM;
    for (int it = rank; it < MTOT / 32; it += nranks) {
        const bf16* ap = F.XB + (size_t)(it * 32 + tile * 16 + r) * DM + 512 * q4 + 8 * kq;
        const bf16* bp = Bt + (size_t)r * DM + 512 * q4 + 8 * kq;
        f32x4 acc[4];
#pragma unroll
        for (int n = 0; n < 4; ++n) acc[n] = (f32x4){0.f, 0.f, 0.f, 0.f};
        XOps R0, R1;
        xops_load(R0, ap, bp, 0); xops_load(R1, ap, bp, 128);
        xops_mma(R0, acc); xops_load(R0, ap, bp, 256);
        xops_mma(R1, acc); xops_load(R1, ap, bp, 384);
        xops_mma(R0, acc); xops_mma(R1, acc);
#pragma unroll
        for (int n = 0; n < 4; ++n)
#pragma unroll
            for (int i = 0; i < 4; ++i) PART[(w * 16 + 4 * kq + i) * 64 + n * 16 + r] = acc[n][i];
        __syncthreads();
        { const int t2 = F.tid >> 8, e = F.tid & 255, row = e >> 4, c4 = (e & 15) * 4;
          f32x4 s = *(const LAS f32x4*)(PART + ((t2 * 4 + 0) * 16 + row) * 64 + c4);
#pragma unroll
          for (int q = 1; q < 4; ++q) s = s + *(const LAS f32x4*)(PART + ((t2 * 4 + q) * 16 + row) * 64 + c4);
          *(f32x4*)(F.EXTRA + (size_t)(it * 32 + t2 * 16 + row) * 64 + c4) = s; }
        __syncthreads();
    }
}

DI f32x4 ldbf4(const bf16* p) { const u32x2 q = *(const u32x2*)p; return (f32x4){__builtin_bit_cast(float, q.x << 16), __builtin_bit_cast(float, q.x & 0xffff0000u), __builtin_bit_cast(float, q.y << 16), __builtin_bit_cast(float, q.y & 0xffff0000u)}; }
DI float ldbf(const bf16* p) { return __builtin_bit_cast(float, (unsigned)(*p) << 16); }
DI float log_sigmoid_(float x) { return fminf(x, 0.f) - __logf(1.f + __expf(-fabsf(x))); }
#define MFMA4(a, b, c) __builtin_amdgcn_mfma_f32_16x16x4f32((a), (b), (c), 0, 0, 0)

constexpr int GLP = 132, G_QH = 0, G_KH = G_QH + 64 * GLP, G_END = G_KH + 64 * GLP;
static_assert(G_END * 4 <= RING_BYTES && 64 * 260 <= G_END, "GLA LDS map");
constexpr int G_X0 = (MISC_OFF + 256) / 4, G_GA = G_X0, G_PART = G_GA + 64 * 16, G_XEND = G_PART + 512;
static_assert(G_XEND * 4 <= LDS_BYTES, "GLA LDS map 2");
#define MFMA16(a, b, c) __builtin_amdgcn_mfma_f32_16x16x32_bf16((a), (b), (c), 0, 0, 0)
DI bf16x8 ld8_f32_as_bf16(const LAS float* p) { const f32x4 a = *(const LAS f32x4*)p, b = *(const LAS f32x4*)(p + 4); u32x4 w; w.x = pk2(a[0], a[1]); w.y = pk2(a[2], a[3]); w.z = pk2(b[0], b[1]); w.w = pk2(b[2], b[3]); return __builtin_bit_cast(bf16x8, w); }

struct PreRegs { u32x2 q[4], k[4], v[8]; f32x4 ga; };
DI void pre_load_qk(Frame& F, PreRegs& R, int item, int tid) {
    const int c = item & 31, h = (item >> 5) & 3, b = item >> 7; const size_t row0 = (size_t)b * TT + 64 * c;
#pragma unroll
    for (int i = 0; i < 4; ++i) { const int idx = tid + 512 * i, row = idx >> 5, c4 = idx & 31; const bf16* g = F.G16 + (row0 + row) * GLAW + h * 128 + 4 * c4;
        R.q[i] = *(const u32x2*)g; R.k[i] = *(const u32x2*)(g + 512); }
    R.ga = (f32x4){0.f, 0.f, 0.f, 0.f};
    if (tid < 256) { const int row = tid >> 2, c4 = tid & 3; R.ga = *(const f32x4*)(F.EXTRA + (row0 + row) * 64 + 4 * c4); }
}
DI void pre_load_v(Frame& F, PreRegs& R, int item, int tid) {
    const int c = item & 31, h = (item >> 5) & 3, b = item >> 7; const size_t row0 = (size_t)b * TT + 64 * c;
#pragma unroll
    for (int i = 0; i < 8; ++i) { const int idx = tid + 512 * i, row = idx >> 6, c4 = idx & 63; R.v[i] = *(const u32x2*)(F.G16 + (row0 + row) * GLAW + 1024 + h * 256 + 4 * c4); }
}
DI f32x4 bf2x2(u32x2 q) { return (f32x4){__builtin_bit_cast(float, q.x << 16), __builtin_bit_cast(float, q.x & 0xffff0000u), __builtin_bit_cast(float, q.y << 16), __builtin_bit_cast(float, q.y & 0xffff0000u)}; }
DI void gla_pre_item(Frame& F, int item, PreRegs& R, int nxt) {
    LAS float* L = (LAS float*)F.lds;
    LAS float *QH = L + G_QH, *KH = L + G_KH, *VS = L, *GA = L + G_GA, *PART = L + G_PART;
    const int tid = F.tid, lane = F.lane, w = F.wave, r16 = lane & 15, kq = lane >> 4;
    const int h = (item >> 5) & 3;
    const int kk = tid & 127, tq = tid >> 7;
    __syncthreads();
#pragma unroll
    for (int i = 0; i < 4; ++i) { const int idx = tid + 512 * i, row = idx >> 5, c4 = idx & 31; *(LAS f32x4*)(QH + row * GLP + 4 * c4) = bf2x2(R.q[i]); *(LAS f32x4*)(KH + row * GLP + 4 * c4) = bf2x2(R.k[i]); }
    if (tid < 256) { const int row = tid >> 2, c4 = tid & 3; *(LAS f32x4*)(GA + row * 16 + 4 * c4) = R.ga; }
    float w2r[16];
#pragma unroll
    for (int r = 0; r < 16; ++r) w2r[r] = F.w_g2[r * 512 + h * 128 + kk];
    const float b2 = F.b_g2[h * 128 + kk];
    __syncthreads();
    float cum[16]; float run = 0.f;
#pragma unroll
    for (int i = 0; i < 16; ++i) { const int t = 16 * tq + i; float x = b2;
#pragma unroll
        for (int r = 0; r < 16; ++r) x += GA[t * 16 + r] * w2r[r];
        run += log_sigmoid_(x) * (1.f / 16.f); cum[i] = run; }
    PART[tq * 128 + kk] = run;
    __syncthreads();
    float off = 0.f;
#pragma unroll
    for (int j = 0; j < 3; ++j) off += (j < tq) ? PART[j * 128 + kk] : 0.f;
#pragma unroll
    for (int i = 0; i < 16; ++i) { const int t = 16 * tq + i; const float e = __expf(cum[i] + off); QH[t * GLP + kk] *= e; KH[t * GLP + kk] *= frcp(e); }
    if (tq == 3) F.GD[(size_t)item * 128 + kk] = __expf(cum[15] + off);
    __syncthreads();
    if (nxt >= 0) pre_load_qk(F, R, nxt, tid);
    { const int row = tid >> 3, c0 = (tid & 7) * 16; bf16* dst = F.GQ + ((size_t)item * 64 + row) * 128 + c0;
      *(bf16x8*)dst = ld8_f32_as_bf16(QH + row * GLP + c0); *(bf16x8*)(dst + 8) = ld8_f32_as_bf16(QH + row * GLP + c0 + 8); }
    { const int k = tid >> 2, j0 = (tid & 3) * 16; float v[16];
#pragma unroll
      for (int j = 0; j < 16; ++j) v[j] = KH[(j0 + j) * GLP + k];
      u32x4 a, bq; a.x = pk2(v[0], v[1]); a.y = pk2(v[2], v[3]); a.z = pk2(v[4], v[5]); a.w = pk2(v[6], v[7]); bq.x = pk2(v[8], v[9]); bq.y = pk2(v[10], v[11]); bq.z = pk2(v[12], v[13]); bq.w = pk2(v[14], v[15]);
      bf16* dst = F.GKT + ((size_t)item * 128 + k) * 64 + j0; *(u32x4*)dst = a; *(u32x4*)(dst + 8) = bq; }
#pragma unroll
    for (int q = 0; q < 2; ++q) { const int tile = 2 * w + q, ti = tile >> 2, tj = tile & 3;
        f32x4 a = {0.f, 0.f, 0.f, 0.f};
        if (tj <= ti) {
#pragma unroll
            for (int s = 0; s < 4; ++s) a = MFMA16(ld8_f32_as_bf16(KH + (16 * tj + r16) * GLP + 32 * s + 8 * kq), ld8_f32_as_bf16(QH + (16 * ti + r16) * GLP + 32 * s + 8 * kq), a);
        }
        const int ri = 16 * ti + r16, cj = 16 * tj + 4 * kq;
        *(u32x2*)(F.GA + ((size_t)item * 64 + ri) * 64 + cj) = (u32x2){pk2(cj <= ri ? a[0] : 0.f, cj + 1 <= ri ? a[1] : 0.f), pk2(cj + 2 <= ri ? a[2] : 0.f, cj + 3 <= ri ? a[3] : 0.f)};
    }
    __syncthreads();
#pragma unroll
    for (int i = 0; i < 8; ++i) { const int idx = tid + 512 * i, row = idx >> 6, c4 = idx & 63; *(LAS f32x4*)(VS + row * 260 + 4 * c4) = bf2x2(R.v[i]); }
    if (nxt >= 0) pre_load_v(F, R, nxt, tid);
    __syncthreads();
    { const int v = tid >> 1, j0 = (tid & 1) * 32; bf16* dst = F.GVT + ((size_t)item * 256 + v) * 64 + j0;
#pragma unroll
      for (int g = 0; g < 4; ++g) { float x[8];
#pragma unroll
          for (int j = 0; j < 8; ++j) x[j] = VS[(j0 + 8 * g + j) * 260 + v];
          u32x4 a; a.x = pk2(x[0], x[1]); a.y = pk2(x[2], x[3]); a.z = pk2(x[4], x[5]); a.w = pk2(x[6], x[7]); *(u32x4*)(dst + 8 * g) = a; } }
}

struct GlaOps { bf16x8 aA0, aA1, aQ0, aQ1, aQ2, aQ3, bK0, bK1; u32x4 vs; float dD; };
DI void gla_seq_load(Frame& F, GlaOps& o, int item, int vs, int w, int r16, int kq, int tid) {
    const int ti = w >> 1;
    const bf16* ga = F.GA + ((size_t)item * 64 + 16 * ti + r16) * 64 + 8 * kq; const bf16* gq = F.GQ + ((size_t)item * 64 + 16 * ti + r16) * 128 + 8 * kq;
    const bf16* gk = F.GKT + ((size_t)item * 128 + 16 * w + r16) * 64 + 8 * kq;
    o.aA0 = *(const bf16x8*)ga; o.aA1 = *(const bf16x8*)(ga + 32); o.bK0 = *(const bf16x8*)gk; o.bK1 = *(const bf16x8*)(gk + 32);
    o.aQ0 = *(const bf16x8*)gq; o.aQ1 = *(const bf16x8*)(gq + 32); o.aQ2 = *(const bf16x8*)(gq + 64); o.aQ3 = *(const bf16x8*)(gq + 96);
    o.vs = *(const u32x4*)(F.GVT + ((size_t)item * 256 + 64 * vs) * 64 + tid * 8);
    o.dD = F.GD[(size_t)item * 128 + 16 * w + r16];
}
DI void gla_seq_step(Frame& F, const GlaOps& cur, const GlaOps& nxt, f32x4 (&acc)[4], LAS bf16* ST, int b, int h, int vs, int c, int w, int r16, int kq, int tid) {
    const int ti = w >> 1, tp = w & 1;
    const LAS bf16* Sc = ST + (c & 1) * 64 * 136; LAS bf16* Sn = ST + ((c & 1) ^ 1) * 64 * 136;
    const LAS bf16* Vc = (const LAS bf16*)((LAS unsigned char*)ST + 69632) + (c & 1) * 64 * 72; LAS bf16* Vn = (LAS bf16*)((LAS unsigned char*)ST + 69632) + ((c & 1) ^ 1) * 64 * 72;
    *(LAS u32x4*)(Vn + (tid >> 3) * 72 + (tid & 7) * 8) = nxt.vs;
    f32x4 o0 = {0.f, 0.f, 0.f, 0.f}, o1 = o0;
    { const LAS bf16* vp = Vc + (32 * tp + r16) * 72 + 8 * kq;
      o0 = MFMA16(cur.aA0, *(const LAS bf16x8*)vp, o0); o0 = MFMA16(cur.aA1, *(const LAS bf16x8*)(vp + 32), o0);
      o1 = MFMA16(cur.aA0, *(const LAS bf16x8*)(vp + 16 * 72), o1); o1 = MFMA16(cur.aA1, *(const LAS bf16x8*)(vp + 16 * 72 + 32), o1); }
    { const LAS bf16* sp = Sc + (32 * tp + r16) * 136 + 8 * kq;
      o0 = MFMA16(cur.aQ0, *(const LAS bf16x8*)sp, o0); o0 = MFMA16(cur.aQ1, *(const LAS bf16x8*)(sp + 32), o0); o0 = MFMA16(cur.aQ2, *(const LAS bf16x8*)(sp + 64), o0); o0 = MFMA16(cur.aQ3, *(const LAS bf16x8*)(sp + 96), o0);
      sp += 16 * 136;
      o1 = MFMA16(cur.aQ0, *(const LAS bf16x8*)sp, o1); o1 = MFMA16(cur.aQ1, *(const LAS bf16x8*)(sp + 32), o1); o1 = MFMA16(cur.aQ2, *(const LAS bf16x8*)(sp + 64), o1); o1 = MFMA16(cur.aQ3, *(const LAS bf16x8*)(sp + 96), o1); }
    { LAS float* ob = (LAS float*)(ST + 2 * 64 * 136) + (c & 1) * 64 * 68 + (16 * ti + 4 * kq) * 68 + 32 * tp + r16;
#pragma unroll
      for (int i = 0; i < 4; ++i) { ob[i * 68] = o0[i]; ob[i * 68 + 16] = o1[i]; } }
#pragma unroll
    for (int tv = 0; tv < 4; ++tv) { const LAS bf16* vp = Vc + (16 * tv + r16) * 72 + 8 * kq;
        acc[tv] = MFMA16(*(const LAS bf16x8*)vp, cur.bK0, acc[tv]); acc[tv] = MFMA16(*(const LAS bf16x8*)(vp + 32), cur.bK1, acc[tv]); acc[tv] = acc[tv] * cur.dD; }
#pragma unroll
    for (int tv = 0; tv < 4; ++tv)
#pragma unroll
        for (int i = 0; i < 4; ++i) Sn[(16 * tv + 4 * kq + i) * 136 + 16 * w + r16] = (bf16)(pk2(acc[tv][i], 0.f) & 0xffffu);
    __syncthreads();
}
DI void gla_seq_flush(Frame& F, LAS bf16* ST, int b, int h, int vs, int c) {
    const int row = F.tid >> 3, seg = F.tid & 7;
    const LAS float* ob = (const LAS float*)(ST + 2 * 64 * 136) + (c & 1) * 64 * 68 + row * 68 + 4 * seg;
    float* op = F.ORAW + ((size_t)b * TT + 64 * c + row) * 1024 + h * 256 + 64 * vs + 4 * seg;
    *(f32x4*)op = *(const LAS f32x4*)ob; *(f32x4*)(op + 32) = *(const LAS f32x4*)(ob + 32);
}
DI void gla_seq_unit(Frame& F, int b, int h, int vs) {
    LAS bf16* ST = (LAS bf16*)F.lds;
    int tid_ = F.tid; asm volatile("" : "+v"(tid_));
    const int tid = tid_, lane = tid & 63, w = F.wave, r16 = lane & 15, kq = lane >> 4;
    __syncthreads();
    for (int i = tid; i < 2 * 64 * 136 / 2; i += 512) ((LAS unsigned*)ST)[i] = 0u;
    f32x4 acc[4];
#pragma unroll
    for (int tv = 0; tv < 4; ++tv) acc[tv] = (f32x4){0.f, 0.f, 0.f, 0.f};
    const int item0 = (b * 4 + h) * 32;
    GlaOps R0, R1, R2;
    gla_seq_load(F, R0, item0, vs, w, r16, kq, tid); gla_seq_load(F, R1, item0 + 1, vs, w, r16, kq, tid);
    *(LAS u32x4*)((LAS bf16*)((LAS unsigned char*)ST + 69632) + (tid >> 3) * 72 + (tid & 7) * 8) = R0.vs;
    __syncthreads();
#pragma unroll 1
    for (int c = 0; c < 30; c += 3) {
        gla_seq_load(F, R2, item0 + c + 2, vs, w, r16, kq, tid); if (c > 0) gla_seq_flush(F, ST, b, h, vs, c - 1); gla_seq_step(F, R0, R1, acc, ST, b, h, vs, c, w, r16, kq, tid);
        gla_seq_load(F, R0, item0 + c + 3, vs, w, r16, kq, tid); gla_seq_flush(F, ST, b, h, vs, c);     gla_seq_step(F, R1, R2, acc, ST, b, h, vs, c + 1, w, r16, kq, tid);
        gla_seq_load(F, R1, item0 + (c + 4 < 32 ? c + 4 : 31), vs, w, r16, kq, tid); gla_seq_flush(F, ST, b, h, vs, c + 1); gla_seq_step(F, R2, R0, acc, ST, b, h, vs, c + 2, w, r16, kq, tid);
    }
    gla_seq_flush(F, ST, b, h, vs, 29); gla_seq_step(F, R0, R1, acc, ST, b, h, vs, 30, w, r16, kq, tid);
    gla_seq_flush(F, ST, b, h, vs, 30); gla_seq_step(F, R1, R1, acc, ST, b, h, vs, 31, w, r16, kq, tid);
    gla_seq_flush(F, ST, b, h, vs, 31);
#pragma unroll
    for (int tv = 0; tv < 4; ++tv)
#pragma unroll
        for (int i = 0; i < 4; ++i) F.out[O_GLAP + ((size_t)(b * 4 + h) * 128 + 16 * w + r16) * 256 + 64 * vs + 16 * tv + 4 * kq + i] = acc[tv][i];
}

DI void gla_sample_unit(Frame& F, int db, int h) {
    LAS float* L = (LAS float*)F.lds;
    LAS float *QH = L, *KH = L + 1024, *VV = L + 2048, *AA = L + 4096, *DD = L + 4160, *GA = L + 4288, *OP = L + 4416;
    const int tid = F.tid, lane = F.lane, w = F.wave;
    const size_t row0 = (size_t)MP + db * 8;
    __syncthreads();
    for (int i = tid; i < 8 * 128; i += 512) { const int t = i >> 7, k = i & 127; QH[i] = ldbf(F.G16 + (row0 + t) * GLAW + h * 128 + k); KH[i] = ldbf(F.G16 + (row0 + t) * GLAW + 512 + h * 128 + k); }
    for (int i = tid; i < 8 * 256; i += 512) { const int t = i >> 8, v = i & 255; VV[i] = ldbf(F.G16 + (row0 + t) * GLAW + 1024 + h * 256 + v); }
    if (tid < 128) GA[tid] = F.EXTRA[(row0 + (tid >> 4)) * 64 + (tid & 15)];
    __syncthreads();
    if (tid < 128) { const int k = tid; float run = 0.f;
        float w2r[16];
#pragma unroll
        for (int r = 0; r < 16; ++r) w2r[r] = F.w_g2[r * 512 + h * 128 + k];
        const float b2 = F.b_g2[h * 128 + k];
#pragma unroll
        for (int t = 0; t < 8; ++t) { float x = b2;
#pragma unroll
            for (int r = 0; r < 16; ++r) x += GA[t * 16 + r] * w2r[r];
            run += log_sigmoid_(x) * (1.f / 16.f); const float e = __expf(run); QH[t * 128 + k] *= e; KH[t * 128 + k] *= frcp(e); }
        DD[k] = __expf(run); }
    __syncthreads();
    if (tid < 64) { const int i = tid >> 3, j = tid & 7; float a = 0.f;
        if (j <= i) for (int k = 0; k < 128; ++k) a += QH[i * 128 + k] * KH[j * 128 + k];
        AA[tid] = a; }
    __syncthreads();
    const int c4 = 4 * lane;
    f32x4 v[8], o[8];
#pragma unroll
    for (int t = 0; t < 8; ++t) { v[t] = *(const LAS f32x4*)(VV + t * 256 + c4); o[t] = (f32x4){0.f, 0.f, 0.f, 0.f}; }
    const float* S0 = F.st_gla + ((size_t)(db * 4 + h) * 128 + 16 * w) * 256 + c4;
    float* S1 = F.out + O_GLAS + ((size_t)(db * 4 + h) * 128 + 16 * w) * 256 + c4;
    f32x4 sv[16];
#pragma unroll
    for (int k = 0; k < 16; ++k) sv[k] = __builtin_nontemporal_load((const f32x4*)(S0 + (size_t)k * 256));
#pragma unroll
    for (int k = 0; k < 16; ++k) { const int kk = 16 * w + k; const f32x4 s = sv[k]; f32x4 acc = s;
#pragma unroll
        for (int t = 0; t < 8; ++t) { o[t] = o[t] + QH[t * 128 + kk] * s; acc = acc + KH[t * 128 + kk] * v[t]; }
        __builtin_nontemporal_store(acc * DD[kk], (f32x4*)(S1 + (size_t)k * 256)); }
#pragma unroll
    for (int t = 0; t < 8; ++t) *(LAS f32x4*)(OP + (w * 8 + t) * 256 + c4) = o[t];
    __syncthreads();
    { const int t = tid >> 6; float ov[4]; float ss = 0.f;
#pragma unroll
        for (int q = 0; q < 4; ++q) { const int cc = lane + 64 * q; float x = 0.f;
#pragma unroll
            for (int g = 0; g < 8; ++g) x += OP[(g * 8 + t) * 256 + cc];
#pragma unroll
            for (int j = 0; j < 8; ++j) x += AA[t * 8 + j] * VV[j * 256 + cc];
            ov[q] = x; ss += x * x; }
        ss = wave_sum(ss); const float rs = 1.f / sqrtf(ss * (1.f / 256.f) + LN_EPS);
#pragma unroll
        for (int q = 0; q < 4; ++q) { const int cc = lane + 64 * q; const float gr = ldbf(F.G16 + (row0 + t) * GLAW + 2048 + h * 256 + cc);
            const float y = ov[q] * rs * F.gnorm[cc] * siluf_(gr);
            F.MIX[(row0 + t) * DM + h * 256 + cc] = (bf16)(pk2(y, 0.f) & 0xffffu); }
    }
    __syncthreads();
}

DI void gla_finalize_phase(Frame& F) {
    int lane = F.lane; asm volatile("" : "+v"(lane));
    const int gw = F.vcu * NWAVES + F.wave, NGW = F.G * NWAVES;
    const f32x4 gn = *(const f32x4*)(F.gnorm + 4 * lane);
    for (int it0 = 4 * gw; it0 < MP * 4; it0 += 4 * NGW) {
        const int row = it0 >> 2;
        f32x4 o[4], gr[4];
#pragma unroll
        for (int h = 0; h < 4; ++h) { o[h] = *(const f32x4*)(F.ORAW + (size_t)row * 1024 + h * 256 + 4 * lane); gr[h] = ldbf4(F.G16 + (size_t)row * GLAW + 2048 + h * 256 + 4 * lane); }
#pragma unroll
        for (int h = 0; h < 4; ++h) {
            const float ss = wave_sum((o[h][0] * o[h][0] + o[h][1] * o[h][1]) + (o[h][2] * o[h][2] + o[h][3] * o[h][3]));
            const float rs = 1.f / sqrtf(ss * (1.f / 256.f) + LN_EPS);
            u32x2 wv; wv.x = pk2(o[h][0] * rs * gn[0] * siluf_(gr[h][0]), o[h][1] * rs * gn[1] * siluf_(gr[h][1])); wv.y = pk2(o[h][2] * rs * gn[2] * siluf_(gr[h][2]), o[h][3] * rs * gn[3] * siluf_(gr[h][3]));
            *(u32x2*)(F.MIX + (size_t)row * DM + h * 256 + 4 * lane) = wv; }
    }
}

DI float gelu_tanh_(float x) { const float u = 0.7978845608028654f * (x + 0.044715f * x * x * x); const float e = fexp2(2.f * u * LOG2E); const float th = 1.f - 2.f * frcp(e + 1.f); return 0.5f * x * (1.f + th); }
DI void zc_load(const bf16* Z, u32x4 (&za)[4], u32x4 (&zb)[4], int tid) {
    const int n8 = (tid & 15) * 8, i0 = tid >> 4;
#pragma unroll
    for (int q = 0; q < 4; ++q) { const int i = i0 + 32 * q; za[q] = *(const u32x4*)(Z + (size_t)i * 256 + n8); zb[q] = *(const u32x4*)(Z + (size_t)(i < 127 ? i + 1 : i) * 256 + 128 + n8); }
}
DI float bflo(unsigned u) { return __builtin_bit_cast(float, u << 16); }
DI float bfhi(unsigned u) { return __builtin_bit_cast(float, u & 0xffff0000u); }
DI void zcombine_phase(Frame& F, int rank, int nranks) {
    LAS bf16* W2T = (LAS bf16*)F.lds; LAS bf16* Y = (LAS bf16*)(F.lds + 34816);
    const int tid = F.tid, lane = F.lane, w = F.wave, r16 = lane & 15, kq = lane >> 4;
    const bf16* ZB = (const bf16*)F.ZC;
    __syncthreads();
    for (int e = tid; e < 2 * 128 * 64; e += 512) { const int kv = e >> 13, n = (e >> 6) & 127, d = e & 63; W2T[(kv * 64 + d) * 136 + n] = (bf16)(pk2(F.cw2[e], 0.f) & 0xffffu); }
    const int ngroups = 2 * NSEQ * 4;
    u32x4 za[4], zb[4];
    int gidx = rank;
    if (gidx < ngroups) zc_load(ZB + (size_t)gidx * 128 * 256, za, zb, tid);
    __syncthreads();
    for (; gidx < ngroups; gidx += nranks) {
        const int kv = gidx / (NSEQ * 4), sh = gidx % (NSEQ * 4);
        { const int n8 = (tid & 15) * 8, i0 = tid >> 4; const f32x4 cb0 = *(const f32x4*)(F.CBIAS + kv * 128 + n8), cb1 = *(const f32x4*)(F.CBIAS + kv * 128 + n8 + 4);
#pragma unroll
          for (int q = 0; q < 4; ++q) { const int i = i0 + 32 * q; float y[8];
              y[0] = bflo(za[q].x) + bflo(zb[q].x) + cb0[0]; y[1] = bfhi(za[q].x) + bfhi(zb[q].x) + cb0[1]; y[2] = bflo(za[q].y) + bflo(zb[q].y) + cb0[2]; y[3] = bfhi(za[q].y) + bfhi(zb[q].y) + cb0[3];
              y[4] = bflo(za[q].z) + bflo(zb[q].z) + cb1[0]; y[5] = bfhi(za[q].z) + bfhi(zb[q].z) + cb1[1]; y[6] = bflo(za[q].w) + bflo(zb[q].w) + cb1[2]; y[7] = bfhi(za[q].w) + bfhi(zb[q].w) + cb1[3];
#pragma unroll
              for (int j = 0; j < 8; ++j) y[j] = (i == 127) ? 0.f : gelu_tanh_(y[j]);
              *(LAS u32x4*)(Y + i * 136 + n8) = (u32x4){pk2(y[0], y[1]), pk2(y[2], y[3]), pk2(y[4], y[5]), pk2(y[6], y[7])}; } }
        __syncthreads();
        if (gidx + nranks < ngroups) zc_load(ZB + (size_t)(gidx + nranks) * 128 * 256, za, zb, tid);
        f32x4 acc[4];
#pragma unroll
        for (int t = 0; t < 4; ++t) acc[t] = (f32x4){0.f, 0.f, 0.f, 0.f};
#pragma unroll
        for (int s = 0; s < 4; ++s) { const bf16x8 yb = *(const LAS bf16x8*)(Y + (16 * w + r16) * 136 + 32 * s + 8 * kq);
#pragma unroll
            for (int t = 0; t < 4; ++t) acc[t] = __builtin_amdgcn_mfma_f32_16x16x32_bf16(*(const LAS bf16x8*)(W2T + (kv * 64 + 16 * t + r16) * 136 + 32 * s + 8 * kq), yb, acc[t], 0, 0, 0); }
        { bf16* dst = (kv == 0 ? F.KC16 : F.VCT16) + ((size_t)sh * 128 + 16 * w + r16) * 64 + 4 * kq;
#pragma unroll
          for (int t = 0; t < 4; ++t) *(u32x2*)(dst + 16 * t) = (u32x2){pk2(acc[t][0], acc[t][1]), pk2(acc[t][2], acc[t][3])}; }
        __syncthreads();
    }
}

#define MFMA32(a, b, c) __builtin_amdgcn_mfma_f32_32x32x16_bf16((a), (b), (c), 0, 0, 0)
struct AState { float m, l; f32x16 o0, o1; };
DI f32x16 zero16() { f32x16 z;
#pragma unroll
    for (int i = 0; i < 16; ++i) z[i] = 0.f; return z; }
DI void astate_init(AState& s) { s.m = -1e30f; s.l = 0.f; s.o0 = zero16(); s.o1 = zero16(); }
DI f32x16 qk_tile32(const LAS bf16* Kt, int KP, const bf16x8 (&qf)[4], int r, int h) {
    f32x16 acc = zero16();
#pragma unroll
    for (int s = 0; s < 4; ++s) { const bf16x8 kf = *(const LAS bf16x8*)(Kt + r * KP + 16 * s + 8 * h); acc = MFMA32(kf, qf[s], acc); }
    return acc;
}
typedef short v4i16_t __attribute__((ext_vector_type(4)));
DI s16x4 lds_tr(const LAS bf16* p) { return __builtin_bit_cast(s16x4, __builtin_amdgcn_ds_read_tr16_b64_v4i16((LAS v4i16_t*)p)); }
DI void pv_tile32(f32x16& o0, f32x16& o1, const LAS bf16* Vr, int VP, const f32x16& p, int lane) {
    const int h = lane >> 5, blk = (lane >> 4) & 1, q = (lane & 15) >> 2, pp = lane & 3;
    const LAS bf16* base = Vr + (4 * h + q) * VP + 16 * blk + 4 * pp;
#pragma unroll
    for (int s = 0; s < 2; ++s) {
        u32x4 pw; pw.x = pk2(p[8 * s], p[8 * s + 1]); pw.y = pk2(p[8 * s + 2], p[8 * s + 3]); pw.z = pk2(p[8 * s + 4], p[8 * s + 5]); pw.w = pk2(p[8 * s + 6], p[8 * s + 7]);
        const bf16x8 pf = __builtin_bit_cast(bf16x8, pw);
        { const s16x4 lo = lds_tr(base + 16 * s * VP), hi = lds_tr(base + (16 * s + 8) * VP);
          o0 = MFMA32(__builtin_shufflevector(lo, hi, 0, 1, 2, 3, 4, 5, 6, 7), pf, o0); }
        { const s16x4 lo = lds_tr(base + 16 * s * VP + 32), hi = lds_tr(base + (16 * s + 8) * VP + 32);
          o1 = MFMA32(__builtin_shufflevector(lo, hi, 0, 1, 2, 3, 4, 5, 6, 7), pf, o1); }
    }
}
DI float xhalf_max(float v) { return fmaxf(v, __shfl_xor(v, 32)); }
DI float xhalf_sum(float v) { return v + __shfl_xor(v, 32); }
DI void block_online(AState& st, const LAS bf16* Kt, int KP, const LAS bf16* Vt, int VP, const bf16x8 (&qf)[4], int kbase, int lo, int hi, bool flag, int r, int h) {
    const bool any = flag && (kbase + 63 >= lo) && (kbase <= hi);
    if (__ballot(any) == 0ull) return;
    f32x16 s0 = qk_tile32(Kt, KP, qf, r, h); __builtin_amdgcn_sched_barrier(0);
    f32x16 s1 = qk_tile32(Kt + 32 * KP, KP, qf, r, h); __builtin_amdgcn_sched_barrier(0);
    const bool cut = flag && !((kbase >= lo) && (kbase + 63 <= hi));
    float mx = -__builtin_inff();
    if (__ballot(cut) != 0ull) {
        const unsigned t0 = (unsigned)(kbase + 4 * h - lo), range = (unsigned)(hi - lo);
#pragma unroll
        for (int reg = 0; reg < 16; ++reg) { const unsigned o = (unsigned)((reg & 3) + 8 * (reg >> 2));
            s0[reg] = (t0 + o <= range) ? s0[reg] : -__builtin_inff(); s1[reg] = (t0 + 32u + o <= range) ? s1[reg] : -__builtin_inff(); mx = fmaxf(mx, fmaxf(s0[reg], s1[reg])); }
    } else {
#pragma unroll
        for (int reg = 0; reg < 16; ++reg) mx = fmaxf(mx, fmaxf(s0[reg], s1[reg]));
    }
    mx = any ? mx : -__builtin_inff();
    mx = xhalf_max(mx);
    const float mn = fmaxf(st.m, mx);
    if (__ballot(mx > st.m) != 0ull) {
        const float alpha = fexp2((st.m - mn) * LOG2E);
        st.l = st.l * alpha; st.o0 = st.o0 * alpha; st.o1 = st.o1 * alpha; st.m = mn;
    }
    const float bias = any ? -mn * LOG2E : -__builtin_inff();
    float sum = 0.f;
#pragma unroll
    for (int reg = 0; reg < 16; ++reg) { s0[reg] = fexp2(__builtin_fmaf(s0[reg], LOG2E, bias)); s1[reg] = fexp2(__builtin_fmaf(s1[reg], LOG2E, bias)); sum += s0[reg] + s1[reg]; }
    st.l += xhalf_sum(sum);
    __builtin_amdgcn_sched_barrier(0);
    pv_tile32(st.o0, st.o1, Vt, VP, s0, r + 32 * h);
    __builtin_amdgcn_sched_barrier(0);
    pv_tile32(st.o0, st.o1, Vt + 32 * VP, VP, s1, r + 32 * h);
}
DI void tile_online(AState& st, const LAS bf16* Kt, int KP, const LAS bf16* Vt, int VP, const bf16x8 (&qf)[4], int kbase, int lo, int hi, bool flag, int r, int h) {
    const bool any = flag && (kbase + 31 >= lo) && (kbase <= hi);
    if (__ballot(any) == 0ull) return;
    f32x16 s = qk_tile32(Kt, KP, qf, r, h);
    const bool cut = flag && !((kbase >= lo) && (kbase + 31 <= hi));
    float mx = -__builtin_inff();
    if (__ballot(cut) != 0ull) {
        const unsigned t0 = (unsigned)(kbase + 4 * h - lo), range = (unsigned)(hi - lo);
#pragma unroll
        for (int reg = 0; reg < 16; ++reg) { s[reg] = (t0 + (unsigned)((reg & 3) + 8 * (reg >> 2)) <= range) ? s[reg] : -__builtin_inff(); mx = fmaxf(mx, s[reg]); }
    } else {
#pragma unroll
        for (int reg = 0; reg < 16; ++reg) mx = fmaxf(mx, s[reg]);
    }
    mx = any ? mx : -__builtin_inff();
    mx = xhalf_max(mx);
    if (__ballot(mx > st.m + 5.5f) != 0ull) {
        const float mn2 = fmaxf(st.m, mx), alpha = fexp2((st.m - mn2) * LOG2E);
        st.l = st.l * alpha; st.o0 = st.o0 * alpha; st.o1 = st.o1 * alpha; st.m = mn2;
    }
    const float mn = st.m;
    const float bias = any ? -mn * LOG2E : -__builtin_inff();
    f32x2 sum2 = {0.f, 0.f}; const f32x2 b2 = {bias, bias}, l2 = {LOG2E, LOG2E};
#pragma unroll
    for (int reg = 0; reg < 16; reg += 2) { f32x2 t = {s[reg], s[reg + 1]}; t = __builtin_elementwise_fma(t, l2, b2);
        t[0] = fexp2(t[0]); t[1] = fexp2(t[1]); s[reg] = t[0]; s[reg + 1] = t[1]; sum2 = sum2 + t; }
    st.l += xhalf_sum(sum2[0] + sum2[1]);
    pv_tile32(st.o0, st.o1, Vt, VP, s, r + 32 * h);
}

constexpr int KTP = 72, VTP = 72;
struct StageRegs { u32x4 k, v; };
DI StageRegs stage_load(const bf16* kp, const bf16* vp, int tid) { StageRegs g; g.k = *(const u32x4*)(kp + tid * 8); g.v = *(const u32x4*)(vp + tid * 8); return g; }
DI void stage_store(LAS bf16* KT, LAS bf16* VT, const StageRegs& g, int tid) {
    *(LAS u32x4*)(KT + (tid >> 3) * KTP + (tid & 7) * 8) = g.k; *(LAS u32x4*)(VT + (tid >> 3) * VTP + (tid & 7) * 8) = g.v;
}
DI unsigned select_blocks_wave(LAS float* SC, LAS float* SCI, int lane, int tpos_base, int cur_of_tok0, bool sample) {
    const int tok = lane >> 3, sub = lane & 7;
    const int tpos = tpos_base + tok;
    const int cur = sample ? 32 : (tpos >> 6);
    (void)cur_of_tok0;
    LAS unsigned* SCU = (LAS unsigned*)SCI;
    unsigned long long my[4];
#pragma unroll
    for (int i = 0; i < 4; ++i) { const int s = 4 * sub + i; float v = 0.f;
#pragma unroll
        for (int g = 0; g < 4; ++g) v += SC[(4 * tok + g) * 33 + s] * SC[32 * 33 + 4 * tok + g];
        const bool started = (64 * s <= tpos), forced = (s == 0) || (s == cur) || (s == cur - 1);
        const float sc = started ? (forced ? 1e9f : v) : -1e9f;
        const unsigned bits = __builtin_bit_cast(unsigned, sc), key = (bits & 0x80000000u) ? ~bits : (bits | 0x80000000u);
        SCU[tok * 33 + s] = key; my[i] = ((unsigned long long)key << 5) | (unsigned)(31 - s); }
    __syncthreads();
    unsigned bits = 0u;
    int rank[4];
#pragma unroll
    for (int i = 0; i < 4; ++i) rank[i] = sample ? 1 : 0;
#pragma unroll 8
    for (int sp = 0; sp < 32; ++sp) { const unsigned long long o = ((unsigned long long)SCU[tok * 33 + sp] << 5) | (unsigned)(31 - sp);
#pragma unroll
        for (int i = 0; i < 4; ++i) rank[i] += (o > my[i]) ? 1 : 0; }
    const unsigned long long kmin = ((unsigned long long)0x4E6E6B28u) << 5;
    (void)kmin;
#pragma unroll
    for (int i = 0; i < 4; ++i) { const int s = 4 * sub + i; if (rank[i] < 16 && (64 * s <= tpos)) bits |= 1u << s; }
    bits |= __shfl_xor(bits, 1); bits |= __shfl_xor(bits, 2); bits |= __shfl_xor(bits, 4);
    return __shfl(bits, 8 * ((lane & 31) >> 2));
}

DI void nsa_prompt_unit(Frame& F, int b, int kv, int c) {
    LAS bf16* KT0 = (LAS bf16*)(F.lds), *VT0 = (LAS bf16*)(F.lds + 9216), *KT1 = (LAS bf16*)(F.lds + 18432), *VT1 = (LAS bf16*)(F.lds + 27648);
    LAS float* SC = (LAS float*)(F.lds + 36864 + F.wave * 4480); LAS float* SCI = (LAS float*)(F.lds + 72704 + F.wave * 1056);
    int tid_ = F.tid; asm volatile("" : "+v"(tid_));
    const int tid = tid_, lane = tid & 63, w = F.wave, r = lane & 31, h = lane >> 5;
    const int tok = 64 * c + 8 * w + (r >> 2), g = r & 3, head = kv * 4 + g, qpos = tok;
    const size_t row = (size_t)b * TT + tok;
    bf16x8 qf[4];
#pragma unroll
    for (int s = 0; s < 4; ++s) qf[s] = *(const bf16x8*)(F.NQ + row * 1024 + head * 64 + 16 * s + 8 * h);
    f32x16 out0, out1;
    const float gx0 = F.EXTRA[row * 64 + 16 + head * 3], gx1 = F.EXTRA[row * 64 + 16 + head * 3 + 1], gx2 = F.EXTRA[row * 64 + 16 + head * 3 + 2];
    __syncthreads();
    unsigned selmask;
    {
        const bf16* kc = F.KC16 + ((size_t)(NDB + b) * 4 + kv) * 128 * 64; const bf16* vc = F.VCT16 + ((size_t)(NDB + b) * 4 + kv) * 128 * 64;
        { const StageRegs a = stage_load(kc, vc, tid), bq = stage_load(kc + 64 * 64, vc + 64 * 64, tid); stage_store(KT0, VT0, a, tid); stage_store(KT1, VT1, bq, tid); }
        __syncthreads();
        int hin = (qpos - 31) >> 4; hin = hin > 126 ? 126 : hin;
        float mx = -1e30f;
#pragma unroll
        for (int q = 0; q < 4; ++q) { const f32x16 sq = qk_tile32((q < 2 ? KT0 : KT1) + (q & 1) * 32 * KTP, KTP, qf, r, h);
#pragma unroll
            for (int reg = 0; reg < 16; ++reg) { const int n = 32 * q + 4 * h + (reg & 3) + 8 * (reg >> 2); mx = fmaxf(mx, (n <= hin) ? sq[reg] : -1e30f); }
            __builtin_amdgcn_sched_barrier(0); }
        mx = fmaxf(mx, __shfl_xor(mx, 32));
        float sum = 0.f; float edge[16];
        f32x16 o0 = zero16(), o1 = zero16();
#pragma unroll
        for (int q = 0; q < 4; ++q) { f32x16 pq = qk_tile32((q < 2 ? KT0 : KT1) + (q & 1) * 32 * KTP, KTP, qf, r, h);
#pragma unroll
            for (int reg = 0; reg < 16; ++reg) { const int n = 32 * q + 4 * h + (reg & 3) + 8 * (reg >> 2); pq[reg] = (n <= hin) ? fexp2((pq[reg] - mx) * LOG2E) : 0.f; sum += pq[reg]; }
#pragma unroll
            for (int gq = 0; gq < 4; ++gq) { SC[r * 33 + 8 * q + 2 * gq + h] = (pq[4 * gq] + pq[4 * gq + 1]) + (pq[4 * gq + 2] + pq[4 * gq + 3]); edge[4 * q + gq] = pq[4 * gq + 3]; }
            pv_tile32(o0, o1, (q < 2 ? VT0 : VT1) + (q & 1) * 32 * VTP, VTP, pq, lane);
            __builtin_amdgcn_sched_barrier(0); }
        sum += __shfl_xor(sum, 32);
        const float inv = sum > 0.f ? 1.f / sum : 0.f;
        __syncthreads();
#pragma unroll
        for (int q = 0; q < 4; ++q)
#pragma unroll
            for (int gq = 0; gq < 4; ++gq) SC[r * 33 + 8 * q + 2 * gq + h + 1] += edge[4 * q + gq];
        if (h == 0) SC[32 * 33 + r] = inv;
        const float g0 = sigmoidf_(gx0) * inv;
        out0 = o0 * g0; out1 = o1 * g0;
        __syncthreads();
#ifndef CUT_SEL
        selmask = select_blocks_wave(SC, SCI, lane, 64 * c + 8 * w, c, false);
#else
        selmask = SC[lane];
#endif
    }
    LAS float* OUTW = (LAS float*)(F.lds + 36864) + w * 2048 + lane;
    __syncthreads();
#pragma unroll
    for (int i = 0; i < 16; ++i) { OUTW[i * 64] = out0[i]; OUTW[(16 + i) * 64] = out1[i]; }
#pragma unroll
    for (int s = 0; s < 4; ++s) qf[s] = *(const bf16x8*)(F.NQ + row * 1024 + head * 64 + 16 * s + 8 * h);
#ifndef CUT_SLC
    {
        AState st; astate_init(st);
        int tid2 = tid; asm volatile("" : "+v"(tid2));
        const bf16* kb = F.KB16 + ((size_t)(0 * NB * 4 + b * 4 + kv) * TT) * 64; const bf16* vb = F.VT16 + ((size_t)(0 * NB * 4 + b * 4 + kv) * TT) * 64;
        StageRegs g0 = stage_load(kb, vb, tid2), g1 = g0;
        if (c >= 1) g1 = stage_load(kb + (size_t)64 * 64, vb + (size_t)64 * 64, tid2);
#pragma unroll 1
        for (int j = 0; j <= c; j += 2) {
            const bool two = (j + 1 <= c);
            __syncthreads();
            stage_store(KT0, VT0, g0, tid2); if (two) stage_store(KT1, VT1, g1, tid2);
            __syncthreads();
            if (j + 2 <= c) g0 = stage_load(kb + (size_t)(j + 2) * 64 * 64, vb + (size_t)(j + 2) * 64 * 64, tid2);
            if (j + 3 <= c) g1 = stage_load(kb + (size_t)(j + 3) * 64 * 64, vb + (size_t)(j + 3) * 64 * 64, tid2);
            { const bool fl = (selmask >> j) & 1u;
              tile_online(st, KT0, KTP, VT0, VTP, qf, 64 * j, 0, qpos, fl, r, h);
              tile_online(st, KT0 + 32 * KTP, KTP, VT0 + 32 * VTP, VTP, qf, 64 * j + 32, 0, qpos, fl, r, h);
              __builtin_amdgcn_sched_barrier(0); }
            if (two) { const bool fl = (selmask >> (j + 1)) & 1u;
              tile_online(st, KT1, KTP, VT1, VTP, qf, 64 * j + 64, 0, qpos, fl, r, h);
              tile_online(st, KT1 + 32 * KTP, KTP, VT1 + 32 * VTP, VTP, qf, 64 * j + 96, 0, qpos, fl, r, h);
              __builtin_amdgcn_sched_barrier(0); }
        }
        int l2 = lane; asm volatile("" : "+v"(l2));
        const int r2 = l2 & 31; const size_t row2 = (size_t)b * TT + 64 * c + 8 * w + (r2 >> 2);
        const float sc = sigmoidf_(gx1) * (st.l > 0.f ? 1.f / st.l : 0.f);
#pragma unroll
        for (int i = 0; i < 16; ++i) { OUTW[i * 64] += st.o0[i] * sc; OUTW[(16 + i) * 64] += st.o1[i] * sc; }
    }
#endif
#ifndef CUT_WIN
    {
        AState st; astate_init(st);
        const int jlo = c >= 8 ? c - 8 : 0;
        int tid3 = tid; asm volatile("" : "+v"(tid3));
        const bf16* kb = F.KB16 + ((size_t)(1 * NB * 4 + b * 4 + kv) * TT) * 64; const bf16* vb = F.VT16 + ((size_t)(1 * NB * 4 + b * 4 + kv) * TT) * 64;
        StageRegs g0 = stage_load(kb + (size_t)jlo * 64 * 64, vb + (size_t)jlo * 64 * 64, tid3), g1 = g0;
        if (jlo + 1 <= c) g1 = stage_load(kb + (size_t)(jlo + 1) * 64 * 64, vb + (size_t)(jlo + 1) * 64 * 64, tid3);
#pragma unroll 1
        for (int j = jlo; j <= c; j += 2) {
            const bool two = (j + 1 <= c);
            __syncthreads();
            stage_store(KT0, VT0, g0, tid3); if (two) stage_store(KT1, VT1, g1, tid3);
            __syncthreads();
            if (j + 2 <= c) g0 = stage_load(kb + (size_t)(j + 2) * 64 * 64, vb + (size_t)(j + 2) * 64 * 64, tid3);
            if (j + 3 <= c) g1 = stage_load(kb + (size_t)(j + 3) * 64 * 64, vb + (size_t)(j + 3) * 64 * 64, tid3);
            tile_online(st, KT0, KTP, VT0, VTP, qf, 64 * j, qpos - 511, qpos, true, r, h);
            tile_online(st, KT0 + 32 * KTP, KTP, VT0 + 32 * VTP, VTP, qf, 64 * j + 32, qpos - 511, qpos, true, r, h);
            if (two) {
              tile_online(st, KT1, KTP, VT1, VTP, qf, 64 * j + 64, qpos - 511, qpos, true, r, h);
              tile_online(st, KT1 + 32 * KTP, KTP, VT1 + 32 * VTP, VTP, qf, 64 * j + 96, qpos - 511, qpos, true, r, h);
              __builtin_amdgcn_sched_barrier(0); }
        }
        int l2 = lane; asm volatile("" : "+v"(l2));
        const int r2 = l2 & 31; const size_t row2 = (size_t)b * TT + 64 * c + 8 * w + (r2 >> 2);
        const float sc = sigmoidf_(gx2) * (st.l > 0.f ? 1.f / st.l : 0.f);
#pragma unroll
        for (int i = 0; i < 16; ++i) { out0[i] = OUTW[i * 64] + st.o0[i] * sc; out1[i] = OUTW[(16 + i) * 64] + st.o1[i] * sc; }
    }
#endif
    int l3 = lane; asm volatile("" : "+v"(l3));
    const int r3 = l3 & 31, h3 = l3 >> 5; const size_t row3 = (size_t)b * TT + 64 * c + 8 * w + (r3 >> 2);
    bf16* mp = F.MIX + row3 * DM + 1024 + (kv * 4 + (r3 & 3)) * 64;
#pragma unroll
    for (int gq = 0; gq < 4; ++gq) {
        u32x2 a; a.x = pk2(out0[4 * gq], out0[4 * gq + 1]); a.y = pk2(out0[4 * gq + 2], out0[4 * gq + 3]); *(u32x2*)(mp + 8 * gq + 4 * h3) = a;
        u32x2 bq; bq.x = pk2(out1[4 * gq], out1[4 * gq + 1]); bq.y = pk2(out1[4 * gq + 2], out1[4 * gq + 3]); *(u32x2*)(mp + 32 + 8 * gq + 4 * h3) = bq;
    }
    __syncthreads();
}

constexpr int SKP = 72, SVP = 72;
struct SampRegs { f32x4 kx[8], vx[8]; unsigned ok; };
template <class RowPtr>
DI void sample_issue(SampRegs& R, const RowPtr& rp, const float* dummy, int tid_in) {
    int tid = tid_in; asm volatile("" : "+v"(tid));
    const int krow = tid >> 4, piece = tid & 15;
    R.ok = 0u;
#pragma unroll
    for (int p = 0; p < 8; ++p) { const float* sp = rp(32 * p + krow); R.ok |= (sp ? 1u : 0u) << p; const float* a = (sp ? sp : dummy) + 4 * piece;
        R.kx[p] = __builtin_nontemporal_load((const f32x4*)a); R.vx[p] = __builtin_nontemporal_load((const f32x4*)(a + 256)); }
}
DI void sample_commit(LAS bf16* KT, LAS bf16* VT, const SampRegs& R, int tid_in) {
    int tid = tid_in; asm volatile("" : "+v"(tid));
    const int krow = tid >> 4, piece = tid & 15;
#pragma unroll
    for (int p = 0; p < 8; ++p) { const int key = 32 * p + krow; const bool ok = (R.ok >> p) & 1u; const f32x4 a = ok ? R.kx[p] : (f32x4){0.f, 0.f, 0.f, 0.f}, b = ok ? R.vx[p] : (f32x4){0.f, 0.f, 0.f, 0.f};
        *(LAS u32x2*)(KT + key * SKP + 4 * piece) = (u32x2){pk2(a[0], a[1]), pk2(a[2], a[3])};
        *(LAS u32x2*)(VT + key * SVP + 4 * piece) = (u32x2){pk2(b[0], b[1]), pk2(b[2], b[3])}; }
}
struct SlcRows { const float* c_slc; const float* newrows; const LAS int* ptab; unsigned uni; int db, kv, sb;
    DI const float* operator()(int key) const {
        if (sb < 8) { const int j = 4 * sb + (key >> 6); if (!((uni >> j) & 1u)) return nullptr; const int page = ptab[j >> 1];
            return c_slc + ((size_t)page * 128 + (j & 1) * 64 + (key & 63)) * 512 + kv * 64; }
        return key < 8 ? newrows + ((size_t)db * 8 + key) * 512 + kv * 64 : nullptr; } };
struct WinRows { const float* c_win; const float* newrows; int db, kv, sb;
    DI const float* operator()(int key) const {
        if (sb < 2) return c_win + ((size_t)db * 512 + 256 * sb + key) * 512 + kv * 64;
        return key < 8 ? newrows + ((size_t)db * 512 + 504 + key) * 512 + kv * 64 : nullptr; } };
DI void sample_merge(Frame& F, LAS float* XM, LAS float* XL, const float mw, const float lw, const f32x16& o0, const f32x16& o1, float gate, f32x4& fin, int w, int r, int h) {
    LAS float* RED = (LAS float*)F.lds;
    __syncthreads();
    if (h == 0) { XM[w * 32 + r] = mw; XL[w * 32 + r] = lw; }
    __syncthreads();
    float m = -1e30f;
#pragma unroll
    for (int i = 0; i < 8; ++i) m = fmaxf(m, XM[i * 32 + r]);
    float l = 0.f;
#pragma unroll
    for (int i = 0; i < 8; ++i) l += XL[i * 32 + r] * fexp2((XM[i * 32 + r] - m) * LOG2E);
    const float f = (l > 0.f) ? gate * fexp2((mw - m) * LOG2E) / l : 0.f;
#pragma unroll
    for (int reg = 0; reg < 16; ++reg) { const int d = (reg & 3) + 8 * (reg >> 2) + 4 * h; RED[(w * 32 + r) * 64 + d] = o0[reg] * f; RED[(w * 32 + r) * 64 + 32 + d] = o1[reg] * f; }
    __syncthreads();
    { const int q = F.tid >> 4, d4 = (F.tid & 15) * 4;
#pragma unroll
      for (int i = 0; i < 8; ++i) fin = fin + *(const LAS f32x4*)(RED + (i * 32 + q) * 64 + d4); }
    __syncthreads();
}
DI void nsa_sample_unit(Frame& F, int db, int kv) {
    LAS bf16* KT = (LAS bf16*)(F.lds), *VT = (LAS bf16*)(F.lds + 36864);
    LAS float *SC = (LAS float*)(F.lds + 73728), *SCI = (LAS float*)(F.lds + 78208), *XM = (LAS float*)(F.lds + 79264), *XL = (LAS float*)(F.lds + 80288);
    LAS unsigned* SMASK = (LAS unsigned*)(F.lds + 81312); LAS int* PT = (LAS int*)(F.lds + 81408);
    int tid_ = F.tid; asm volatile("" : "+v"(tid_));
    const int tid = tid_, lane = tid & 63, w = F.wave, r = lane & 31, h = lane >> 5;
    const int ts = r >> 2, g = r & 3, head = kv * 4 + g, qpos = TT + ts;
    const size_t row = (size_t)MP + db * 8 + ts;
    bf16x8 qf[4];
#pragma unroll
    for (int s = 0; s < 4; ++s) qf[s] = *(const bf16x8*)(F.NQ + row * 1024 + head * 64 + 16 * s + 8 * h);
    const float* gp = F.EXTRA + row * 64 + 16 + head * 3;
    const float g0 = sigmoidf_(gp[0]), g1 = sigmoidf_(gp[1]), g2 = sigmoidf_(gp[2]);
    f32x4 fin = {0.f, 0.f, 0.f, 0.f};
    __syncthreads();
    if (tid < 16) PT[tid] = F.ptab[db * 16 + tid];
    {
        const bf16* kc = F.KC16 + ((size_t)db * 4 + kv) * 128 * 64; const bf16* vc = F.VCT16 + ((size_t)db * 4 + kv) * 128 * 64;
#pragma unroll
        for (int q = 0; q < 2; ++q) { const int e = tid + 512 * q;
            *(LAS u32x4*)(KT + (e >> 3) * SKP + (e & 7) * 8) = *(const u32x4*)(kc + e * 8); *(LAS u32x4*)(VT + (e >> 3) * SVP + (e & 7) * 8) = *(const u32x4*)(vc + e * 8); }
        __syncthreads();
        f32x16 p = zero16(); float mw = -1e30f, lw = 0.f;
        if (w < 4) {
            p = qk_tile32(KT + 32 * w * SKP, SKP, qf, r, h);
#pragma unroll
            for (int reg = 0; reg < 16; ++reg) { const int n = 32 * w + 4 * h + (reg & 3) + 8 * (reg >> 2); p[reg] = (n <= 126) ? p[reg] : -1e30f; mw = fmaxf(mw, p[reg]); }
            mw = fmaxf(mw, __shfl_xor(mw, 32));
#pragma unroll
            for (int reg = 0; reg < 16; ++reg) { p[reg] = (p[reg] > -1e29f) ? fexp2((p[reg] - mw) * LOG2E) : 0.f; lw += p[reg]; }
            lw += __shfl_xor(lw, 32);
        }
        if (h == 0) { XM[w * 32 + r] = mw; XL[w * 32 + r] = lw; }
        __syncthreads();
        float m = -1e30f;
#pragma unroll
        for (int i = 0; i < 8; ++i) m = fmaxf(m, XM[i * 32 + r]);
        float l = 0.f;
#pragma unroll
        for (int i = 0; i < 8; ++i) l += XL[i * 32 + r] * fexp2((XM[i * 32 + r] - m) * LOG2E);
        const float f = (l > 0.f) ? fexp2((mw - m) * LOG2E) / l : 0.f;
        p = p * f;
        if (w < 4) {
#pragma unroll
            for (int gq = 0; gq < 4; ++gq) SC[r * 33 + 8 * w + 2 * gq + h] = (p[4 * gq] + p[4 * gq + 1]) + (p[4 * gq + 2] + p[4 * gq + 3]);
        }
        if (w == 4 && h == 0) SC[32 * 33 + r] = 1.f;
        __syncthreads();
        f32x16 o0 = zero16(), o1 = zero16();
        if (w < 4) {
#pragma unroll
            for (int gq = 0; gq < 4; ++gq) SC[r * 33 + 8 * w + 2 * gq + h + 1] += p[4 * gq + 3];
            pv_tile32(o0, o1, VT + 32 * w * SVP, SVP, p, lane);
        }
        __syncthreads();
        unsigned bits = select_blocks_wave(SC, SCI, lane, TT, 32, true);
        if (w == 0 && lane < 32 && (lane & 3) == 0) SMASK[lane >> 2] = bits;
        sample_merge(F, XM, XL, 0.f, (w == 0) ? 1.f : 0.f, o0, o1, g0, fin, w, r, h);
    }
    const unsigned selmask = SMASK[ts];
    unsigned uni = 0u;
#pragma unroll
    for (int i = 0; i < 8; ++i) uni |= SMASK[i];
    {
        AState st; astate_init(st);
        SampRegs R;
        { const SlcRows rp{F.c_slc, F.out + O_SLCS, PT, uni, db, kv, 0}; sample_issue(R, rp, F.c_win, tid); }
#pragma unroll 1
        for (int sb = 0; sb < 9; ++sb) {
            __syncthreads();
            sample_commit(KT, VT, R, tid);
            __syncthreads();
            if (sb + 1 < 9) { const SlcRows rp{F.c_slc, F.out + O_SLCS, PT, uni, db, kv, sb + 1}; sample_issue(R, rp, F.c_win, tid); }
            const int j = 4 * sb + (w >> 1);
            const bool fl = (j >= 32) ? true : ((selmask >> j) & 1u);
            tile_online(st, KT + 32 * w * SKP, SKP, VT + 32 * w * SVP, SVP, qf, 256 * sb + 32 * w, 0, qpos, fl, r, h);
        }
        sample_merge(F, XM, XL, st.m, st.l, st.o0, st.o1, g1, fin, w, r, h);
    }
    {
        AState st; astate_init(st);
        SampRegs R;
        { const WinRows rp{F.c_win, F.out + O_WINS, db, kv, 0}; sample_issue(R, rp, F.c_win, tid); }
#pragma unroll 1
        for (int sb = 0; sb < 3; ++sb) {
            __syncthreads();
            sample_commit(KT, VT, R, tid);
            __syncthreads();
            if (sb + 1 < 3) { const WinRows rp{F.c_win, F.out + O_WINS, db, kv, sb + 1}; sample_issue(R, rp, F.c_win, tid); }
            tile_online(st, KT + 32 * w * SKP, SKP, VT + 32 * w * SVP, SVP, qf, (TT - 512) + 256 * sb + 32 * w, qpos - 511, qpos, true, r, h);
        }
        sample_merge(F, XM, XL, st.m, st.l, st.o0, st.o1, g2, fin, w, r, h);
    }
    { const int q = tid >> 4, d4 = (tid & 15) * 4;
      u32x2 wv; wv.x = pk2(fin[0], fin[1]); wv.y = pk2(fin[2], fin[3]);
      *(u32x2*)(F.MIX + ((size_t)MP + db * 8 + (q >> 2)) * DM + 1024 + (kv * 4 + (q & 3)) * 64 + d4) = wv; }
    __syncthreads();
}

#ifndef MK_ONE_LAUNCH
#define MK_ONE_LAUNCH 1
#endif
constexpr int NPHASE = 13;
#ifndef GEMM_SP2
#define GEMM_SP2 true
#endif
#ifndef GEMM_ALIGN
#define GEMM_ALIGN true
#endif
struct Args { const void* in[21]; float* out; unsigned char* ws; int ph_lo, ph_hi; };
static_assert(sizeof(Args) == 21 * 8 + 8 + 8 + 8, "Args has no padding");

__global__ void __launch_bounds__(NWAVES * 64, 2) hybrid_fwd(Args args) {
    extern __shared__ __attribute__((aligned(16))) unsigned char lds[];
    Frame F;
    F.lds = (LAS unsigned char*)lds;
    F.MISC = (volatile LAS unsigned*)(F.lds + MISC_OFF);
    F.tid = threadIdx.x; F.lane = F.tid & 63; F.wave = __builtin_amdgcn_readfirstlane(F.tid >> 6);
    F.G = gridDim.x; { const int bx = blockIdx.x; F.vcu = (F.G % 8 == 0) ? (bx % 8) * (F.G / 8) + bx / 8 : bx; }
    unsigned char* ws = args.ws;
    F.ctl = (gu32*)(ws + WS_CTL);
    F.out = args.out;
    F.x_p = (const float*)args.in[0]; F.x_s = (const float*)args.in[1]; F.c_cmp = (const float*)args.in[2]; F.c_slc = (const float*)args.in[3]; F.c_win = (const float*)args.in[4];
    F.st_gla = (const float*)args.in[5]; F.ptab = (const int*)args.in[6]; F.w1a = (const float*)args.in[7]; F.w1b = (const float*)args.in[8]; F.w_in = (const float*)args.in[9];
    F.w_g2 = (const float*)args.in[10]; F.b_g2 = (const float*)args.in[11]; F.gnorm = (const float*)args.in[12]; F.cpos = (const float*)args.in[13]; F.cw1 = (const float*)args.in[14];
    F.cw2 = (const float*)args.in[15]; F.w_out = (const float*)args.in[16]; F.w2a = (const float*)args.in[17]; F.w2b = (const float*)args.in[18]; F.ln_g = (const float*)args.in[19]; F.ln_b = (const float*)args.in[20];
    F.CBIAS = (float*)(ws + WS_SMALL);
    F.W1A = (bf16*)(ws + WS_W1A); F.W1B = (bf16*)(ws + WS_W1B); F.WIN = (bf16*)(ws + WS_WIN); F.WOUT = (bf16*)(ws + WS_WOUT); F.W2A = (bf16*)(ws + WS_W2A); F.W2B = (bf16*)(ws + WS_W2B);
    F.CW1 = (bf16*)(ws + WS_CW1); F.XB = (bf16*)(ws + WS_XB); F.HB = (bf16*)(ws + WS_HB); F.ZF = (float*)(ws + WS_ZF); F.G16 = (bf16*)(ws + WS_GLAIN); F.NQ = (bf16*)(ws + WS_NQ);
    F.EXTRA = (float*)(ws + WS_EXTRA); F.WINROWS = (float*)(ws + WS_WINROWS); F.ORAW = (float*)(ws + WS_ORAW); F.MIX = (bf16*)(ws + WS_MIX); F.XBLK = (bf16*)(ws + WS_XBLK);
    F.ZC = (float*)(ws + WS_ZC); F.KCMP = (float*)(ws + WS_KCMP);
    F.GQ = (bf16*)(ws + WS_GQ); F.GKT = (bf16*)(ws + WS_GKT); F.GA = (bf16*)(ws + WS_GA); F.GVT = (bf16*)(ws + WS_GVT); F.GD = (float*)(ws + WS_GD); F.SLAB = (float*)(ws + WS_SLAB);
    F.KB16 = (bf16*)(ws + WS_KB16); F.VT16 = (bf16*)(ws + WS_VT16); F.KC16 = (bf16*)(ws + WS_KC16); F.VCT16 = (bf16*)(ws + WS_VCT16);
    for (int u = F.tid; u < (LDS_BYTES - LDSCTL_OFF) / 4; u += NWAVES * 64) ((LAS unsigned*)(F.lds + LDSCTL_OFF))[u] = 0u;
    __syncthreads();
    const int lo = args.ph_lo, hi = args.ph_hi;
    XcdBarrier bar; bar.bar = (unsigned*)(F.ctl + CW_BAR); bar.x = 0; bar.st = nullptr;
    if (hi - lo > 1) bar = xcd_barrier_post((unsigned*)(F.ctl + CW_BAR), F.MISC + 8);
#ifndef PH_MASK
#define PH_MASK 0xFFFF
#endif
#define IN(k) (((PH_MASK >> (k)) & 1) && lo <= (k) && (k) < hi)
#define PH_BEGIN() do { int t_ = threadIdx.x; asm volatile("" : "+v"(t_)); F.tid = t_; F.lane = t_ & 63; F.wave = __builtin_amdgcn_readfirstlane(t_ >> 6); } while (0)
#define SEAM(k) do { if (IN(k) && IN((k) + 1)) xcd_barrier(bar); } while (0)
    const int bx = (int)blockIdx.x;

    if (IN(0)) { PH_BEGIN(); p0_prologue(F); } SEAM(0);
    if (IN(1)) { PH_BEGIN(); pg8::Gemm g{F.XB, F.W1A, MTOT, 2 * DFF, DM}; pg8::StaticOrder S; S.init(MTOT, 2 * DFF, F.G, bx); EpiSwiGLU E{F.HB};
        if (F.vcu & 1) { xblk_part(F, F.vcu, F.G); __syncthreads(); }
        pg8::gemm_phase<EpiSwiGLU, pg8::StaticOrder, GEMM_ALIGN, GEMM_SP2>(F.lds, g, S, E);
        if (!(F.vcu & 1)) { __syncthreads(); xblk_part(F, F.vcu, F.G); }
        late_tail(F, 1, bx, (MTOT / 256) * (2 * DFF / 256));
 } SEAM(1);
#ifndef REP_FFO
#define REP_FFO 1
#endif
#ifdef EXP_HOTA
    if (IN(2)) { struct HotOrder : pg8::StaticOrder { DI bool next(int i, pg8::Unit& u) const { const bool r = pg8::StaticOrder::next(i, u); u.pm = u.pm & 7; return r; } };
        pg8::Gemm g{F.HB, F.W1B, MP, DM, DFF, 0}; HotOrder S; S.init(MP, DM, F.G, bx); EpiResid E{F.x_p, (bf16*)F.ORAW, 0.5f};
        pg8::gemm_phase<EpiResid, HotOrder, true, GEMM_SP2>(F.lds, g, S, E); }
#endif
    if (IN(2)) { PH_BEGIN(); for (int rep = 0; rep < REP_FFO; ++rep) { pg8::Gemm g{F.HB, F.W1B, MP, DM, DFF, 0}; pg8::StaticOrder S; S.init(MP, DM, F.G, bx); EpiResid E{F.x_p, (bf16*)F.ZF, 0.5f};
          pg8::gemm_phase<EpiResid, pg8::StaticOrder, GEMM_ALIGN, GEMM_SP2>(F.lds, g, S, E); }
        { pg8::Gemm g{F.HB, F.W1B, MTOT, DM, DFF / NSPLIT, DFF}; SplitOrder S{F.G, bx, (DFF / NSPLIT) * 2}; EpiSlab E{F.SLAB, (DFF / NSPLIT) * 2};
          pg8::gemm_phase<EpiSlab, SplitOrder, GEMM_ALIGN, GEMM_SP2>(F.lds, g, S, E); }
        late_tail(F, 2, bx, 32 * NSPLIT); } SEAM(2);
    if (IN(3)) { PH_BEGIN(); ln_phase(F, (const bf16*)F.ZF, nullptr, F.XB, F.ln_g, F.ln_b, F.x_s, nullptr, 0.5f); } SEAM(3);
    if (IN(4)) { PH_BEGIN(); pg8::Gemm g{F.XB, F.WIN, MTOT, NIN, DM}; pg8::StaticOrder S; S.init(MTOT, NIN, F.G, bx); EpiInProj E{F.G16, F.NQ, F.out, F.WINROWS, F.XBLK, F.KB16, F.VT16};
#ifndef REP_EXTRA
#define REP_EXTRA 1
#endif
        if (F.vcu & 1) { for (int rep = 0; rep < REP_EXTRA; ++rep) extra_phase(F, F.G - 1 - bx, F.G); __syncthreads(); }
        pg8::gemm_phase<EpiInProj, pg8::StaticOrder, GEMM_ALIGN, GEMM_SP2>(F.lds, g, S, E);
        if (!(F.vcu & 1)) { __syncthreads(); for (int rep = 0; rep < REP_EXTRA; ++rep) extra_phase(F, F.G - 1 - bx, F.G); }
        late_tail(F, 4, bx, (MTOT / 256) * (NIN / 256)); } SEAM(4);
    if (IN(5)) { PH_BEGIN();
#ifndef REP_GPRE
#define REP_GPRE 1
#endif
#ifndef REP_GSMP
#define REP_GSMP 1
#endif
#ifndef REP_CGEMM
#define REP_CGEMM 1
#endif
#ifndef REP_GSEQ
#define REP_GSEQ 1
#endif
#ifndef REP_ZC
#define REP_ZC 1
#endif
        const bool gemm_first = (F.vcu & 1) != 0;
        if (gemm_first) { __syncthreads();
            for (int rep = 0; rep < REP_CGEMM; ++rep) { pg8::Gemm g{F.XBLK, F.CW1, 2 * XROWS, 512, 1024}; CmpOrder S{F.G, bx}; EpiZ E{(bf16*)F.ZC};
              pg8::gemm_phase<EpiZ, CmpOrder, GEMM_ALIGN, GEMM_SP2>(F.lds, g, S, E); }
            __syncthreads(); }
        for (int rep = 0; rep < REP_GPRE; ++rep) { PreRegs PR; if (F.vcu < NB * 4 * 32) { pre_load_qk(F, PR, F.vcu, F.tid); pre_load_v(F, PR, F.vcu, F.tid); }
            for (int it = F.vcu; it < NB * 4 * 32; it += F.G) gla_pre_item(F, it, PR, it + F.G < NB * 4 * 32 ? it + F.G : -1); }
        for (int rep = 0; rep < REP_GSMP; ++rep) for (int u = F.vcu; u < NDB * 4; u += F.G) gla_sample_unit(F, u >> 2, u & 3);
        __syncthreads();
        if (!gemm_first) {
            for (int rep = 0; rep < REP_CGEMM; ++rep) { pg8::Gemm g{F.XBLK, F.CW1, 2 * XROWS, 512, 1024}; CmpOrder S{F.G, bx}; EpiZ E{(bf16*)F.ZC};
              pg8::gemm_phase<EpiZ, CmpOrder, GEMM_ALIGN, GEMM_SP2>(F.lds, g, S, E); }
            __syncthreads(); }
        late_tail(F, 5, bx, 2 * (XROWS / 256));
    } SEAM(5);
    if (IN(6)) { PH_BEGIN();
        const int nseq = NB * 4 * 4;
        if (F.G == 2 * nseq) { const int u = F.vcu >> 1;
                               if ((F.vcu & 1) == 0) { for (int rep = 0; rep < REP_GSEQ; ++rep) gla_seq_unit(F, u >> 4, (u >> 2) & 3, u & 3); }
                               else { for (int rep = 0; rep < REP_ZC; ++rep) zcombine_phase(F, u, nseq); } }
        else { for (int u = F.vcu; u < nseq; u += F.G) gla_seq_unit(F, u >> 4, (u >> 2) & 3, u & 3); zcombine_phase(F, F.vcu, F.G); } } SEAM(6);
#ifdef EXP_BARS
    if (IN(6) && IN(7)) { for (int q = 0; q < 8; ++q) xcd_barrier(bar); }
#endif
    if (IN(7)) { PH_BEGIN();
#ifndef REP_NSAP
#define REP_NSAP 1
#endif
#ifndef REP_NSAS
#define REP_NSAS 1
#endif
#pragma unroll 1
        for (int half = 0; half < 2; ++half) {
            if ((half ^ (F.vcu & 1)) == 0) {
                for (int rep = 0; rep < REP_NSAP; ++rep)
                for (int U = F.vcu; U < 1024; U += F.G) { const int i = U >> 8, id = U & 255, bk = id >> 3, q = id & 7; const int c = i == 0 ? q : (i == 1 ? 15 - q : (i == 2 ? 16 + q : 31 - q));
                    nsa_prompt_unit(F, bk >> 2, bk & 3, c); }
            } else {
                for (int rep = 0; rep < REP_NSAS; ++rep)
                for (int u = F.vcu; u < NDB * 4; u += F.G) nsa_sample_unit(F, u >> 2, u & 3);
            }
        }
#ifndef REP_FIN
#define REP_FIN 1
#endif
        for (int rep = 0; rep < REP_FIN; ++rep) gla_finalize_phase(F);
    } SEAM(7);
    if (IN(8)) { PH_BEGIN(); { pg8::Gemm g{F.MIX, F.WOUT, MP, DM, DM, 0}; pg8::StaticOrder S; S.init(MP, DM, F.G, bx); EpiResid16 E{F.XB, (bf16*)F.ZF, 1.0f};
          pg8::gemm_phase<EpiResid16, pg8::StaticOrder, GEMM_ALIGN, GEMM_SP2>(F.lds, g, S, E); }
        { pg8::Gemm g{F.MIX, F.WOUT, MTOT, DM, DM / NSPLIT, DM}; SplitOrder S{F.G, bx, (DM / NSPLIT) * 2}; EpiSlab E{F.SLAB, (DM / NSPLIT) * 2};
          pg8::gemm_phase<EpiSlab, SplitOrder, GEMM_ALIGN, GEMM_SP2>(F.lds, g, S, E); }
        late_tail(F, 8, bx, 32 * NSPLIT); } SEAM(8);
    if (IN(9)) { PH_BEGIN(); ln_phase(F, (const bf16*)F.ZF, nullptr, F.XB, F.ln_g + DM, F.ln_b + DM, nullptr, F.XB + (size_t)MP * DM, 1.0f); } SEAM(9);
    if (IN(10)) { PH_BEGIN(); pg8::Gemm g{F.XB, F.W2A, MTOT, 2 * DFF, DM}; pg8::StaticOrder S; S.init(MTOT, 2 * DFF, F.G, bx); EpiSwiGLU E{F.HB};
        pg8::gemm_phase<EpiSwiGLU, pg8::StaticOrder, GEMM_ALIGN, GEMM_SP2>(F.lds, g, S, E);
        late_tail(F, 10, bx, (MTOT / 256) * (2 * DFF / 256)); } SEAM(10);
    if (IN(11)) { PH_BEGIN(); { pg8::Gemm g{F.HB, F.W2B, MP, DM, DFF, 0}; pg8::StaticOrder S; S.init(MP, DM, F.G, bx); EpiResid16 E{F.XB, (bf16*)F.ZF, 0.5f};
          pg8::gemm_phase<EpiResid16, pg8::StaticOrder, GEMM_ALIGN, GEMM_SP2>(F.lds, g, S, E); }
        { pg8::Gemm g{F.HB, F.W2B, MTOT, DM, DFF / NSPLIT, DFF}; SplitOrder S{F.G, bx, (DFF / NSPLIT) * 2}; EpiSlab E{F.SLAB, (DFF / NSPLIT) * 2};
          pg8::gemm_phase<EpiSlab, SplitOrder, GEMM_ALIGN, GEMM_SP2>(F.lds, g, S, E); }
        late_tail(F, 11, bx, 32 * NSPLIT); } SEAM(11);
    if (IN(12)) { PH_BEGIN(); ln_phase(F, (const bf16*)F.ZF, F.out, nullptr, F.ln_g + 2 * DM, F.ln_b + 2 * DM, nullptr, F.XB + (size_t)MP * DM, 0.5f); }
#undef IN
#undef SEAM
}

extern "C" void kernel_launch(void* const* d_in, const int* in_sizes, int n_in, void* d_out, int out_size, void* d_ws, size_t ws_size, hipStream_t stream) {
    static int grid = 0;
    if (grid == 0) {
        if (n_in != 21 || out_size != (int)O_END || ws_size < WS_END) { fprintf(stderr, "kernel_launch: unexpected shapes: n_in %d out %d ws %zu (need %zu)\n", n_in, out_size, ws_size, (size_t)WS_END); grid = -1; return; }
        int dev = 0, cus = 0;
        if (hipGetDevice(&dev) != hipSuccess || hipDeviceGetAttribute(&cus, hipDeviceAttributeMultiprocessorCount, dev) != hipSuccess) { grid = -1; return; }
        if (hipFuncSetAttribute((const void*)hybrid_fwd, hipFuncAttributeMaxDynamicSharedMemorySize, LDS_BYTES) != hipSuccess) { fprintf(stderr, "kernel_launch: hipFuncSetAttribute failed\n"); grid = -1; return; }
        int per_cu = 0;
        if (hipOccupancyMaxActiveBlocksPerMultiprocessor(&per_cu, (const void*)hybrid_fwd, NWAVES * 64, LDS_BYTES) != hipSuccess || per_cu < 1) fprintf(stderr, "kernel_launch: occupancy query says %d\n", per_cu);
        (void)hipGetLastError();
        grid = cus;
    }
    if (grid < 0) return;
    (void)in_sizes;
    if (hipMemsetAsync((char*)d_ws + WS_CTL, 0, CTL_ZERO_BYTES, stream) != hipSuccess) return;
    Args a{};
    for (int i = 0; i < 21; ++i) a.in[i] = d_in[i];
    a.out = (float*)d_out; a.ws = (unsigned char*)d_ws;
#if MK_ONE_LAUNCH
    a.ph_lo = 0; a.ph_hi = NPHASE;
    hipLaunchKernelGGL(hybrid_fwd, dim3(grid), dim3(NWAVES * 64), LDS_BYTES, stream, a);
#else
#ifndef PROBE_DBL
#define PROBE_DBL 0
#endif
    for (int p = 0; p < NPHASE; ++p) { a.ph_lo = p; a.ph_hi = p + 1;
        for (int rep = 0; rep < 1 + ((PROBE_DBL >> p) & 1); ++rep) hipLaunchKernelGGL(hybrid_fwd, dim3(grid), dim3(NWAVES * 64), LDS_BYTES, stream, a); }
#endif
}
```
